# Optimizing an MI355X kernel written in HIP

```python
import math, functools
import jax, jax.numpy as jnp
from jax import lax
import numpy as np

D_MODEL = 1024
BATCH = 2
SEQ = 8192
DEPTH = 1
DEC_BATCH = 128
DEC_SEQ = 4
PAST_LEN = 16384
PAGE_SIZE = 128

HEAD_DIM = 64
N_HEADS = D_MODEL // HEAD_DIM
N_KV_HEADS = 4
GQA_GROUP = N_HEADS // N_KV_HEADS
WINDOW = 128
BLOCK = WINDOW
D_ATTN = N_HEADS * HEAD_DIM
D_KV = N_KV_HEADS * HEAD_DIM
D_SSM = D_MODEL
SSM_CH = 16
SSM_GROUPS = D_SSM // SSM_CH
SSM_STATE = 64
D_FF = 4 * D_MODEL
RMS_EPS = 1e-5
DT_MIN = 0.001
DT_MAX = 0.1
D_IN = D_ATTN + 2 * D_KV + D_SSM + 2 * D_MODEL

kernel_name = "hybrid_swa_sink_s5_decoder_step"


def rmsnorm(x, g):
    xf = x.astype(jnp.float32)
    y = xf * lax.rsqrt(jnp.mean(xf * xf, axis=-1, keepdims=True) + RMS_EPS)
    return (y * g.astype(jnp.float32)).astype(x.dtype)


def sink_attention(q, k, v, valid, sinks):
    s = jnp.einsum('...qkgd,...skd->...kgqs', q, k,
                   preferred_element_type=jnp.float32) * (HEAD_DIM ** -0.5)
    s = jnp.where(valid, s, -jnp.inf)
    sink = sinks.astype(jnp.float32).reshape(N_KV_HEADS, GQA_GROUP, 1, 1)
    m = jnp.maximum(jnp.max(s, axis=-1, keepdims=True), sink)
    p = jnp.exp(s - m)
    denom = jnp.sum(p, axis=-1, keepdims=True) + jnp.exp(sink - m)
    return jnp.einsum('...kgqs,...skd->...qkgd', (p / denom).astype(v.dtype), v)


def prompt_attention(q, k, v, sinks):
    b, l = q.shape[0], q.shape[1]
    nb = l // BLOCK
    qb = q.reshape(b, nb, BLOCK, N_KV_HEADS, GQA_GROUP, HEAD_DIM)
    kb = k.reshape(b, nb, BLOCK, N_KV_HEADS, HEAD_DIM)
    vb = v.reshape(b, nb, BLOCK, N_KV_HEADS, HEAD_DIM)
    pad = jnp.zeros_like(kb[:, :1])
    k2 = jnp.concatenate([jnp.concatenate([pad, kb[:, :-1]], axis=1), kb], axis=2)
    v2 = jnp.concatenate([jnp.concatenate([pad, vb[:, :-1]], axis=1), vb], axis=2)
    qi = jnp.arange(BLOCK)[:, None]
    si = jnp.arange(2 * BLOCK)[None, :]
    diff = qi + BLOCK - si
    band = (diff >= 0) & (diff < WINDOW)
    has_prev = (jnp.arange(nb) > 0)[:, None, None] | (si >= BLOCK)[None]
    valid = (band[None] & has_prev)[:, None, None]
    o = sink_attention(qb, k2, v2, valid, sinks)
    return (o.reshape(b, l, D_ATTN), k[:, -WINDOW:], v[:, -WINDOW:])


def sample_attention(q, k, v, sinks, cache_k, cache_v):
    b, t = q.shape[0], q.shape[1]
    w = cache_k.shape[1]
    kk = jnp.concatenate([cache_k, k], axis=1)
    vv = jnp.concatenate([cache_v, v], axis=1)
    qpos = PAST_LEN + jnp.arange(t)
    kpos = PAST_LEN - w + jnp.arange(w + t)
    diff = qpos[:, None] - kpos[None, :]
    valid = (diff >= 0) & (diff < WINDOW)
    qg = q.reshape(b, t, N_KV_HEADS, GQA_GROUP, HEAD_DIM)
    o = sink_attention(qg, kk, vv, valid, sinks)
    return (o.reshape(b, t, D_ATTN), kk[:, -WINDOW:], vv[:, -WINDOW:])


def _cplx_affine_combine(e1, e2):
    a1r, a1i, b1r, b1i = e1
    a2r, a2i, b2r, b2i = e2
    return (a2r * a1r - a2i * a1i,
            a2r * a1i + a2i * a1r,
            a2r * b1r - a2i * b1i + b2r,
            a2r * b1i + a2i * b1r + b2i)


def s5_discretize(lam_re, lam_im, log_dt, b_re, b_im):
    dt = jnp.exp(log_dt)[:, None]
    decay = jnp.exp(lam_re * dt)
    ab_re = decay * jnp.cos(lam_im * dt)
    ab_im = decay * jnp.sin(lam_im * dt)
    nr, ni = ab_re - 1.0, ab_im
    den = lam_re * lam_re + lam_im * lam_im
    f_re = ((nr * lam_re + ni * lam_im) / den)[..., None]
    f_im = ((ni * lam_re - nr * lam_im) / den)[..., None]
    bb_re = f_re * b_re - f_im * b_im
    bb_im = f_re * b_im + f_im * b_re
    return ab_re, ab_im, bb_re, bb_im


def s5_branch(u, h0_re, h0_im, lam_re, lam_im, log_dt, b_re, b_im, c_re, c_im, d_skip):
    f32 = jnp.float32
    b, l = u.shape[0], u.shape[1]
    uf = u.astype(f32)
    ug = uf.reshape(b, l, SSM_GROUPS, SSM_CH)
    ab_re, ab_im, bb_re, bb_im = s5_discretize(
        lam_re.astype(f32), lam_im.astype(f32), log_dt.astype(f32), b_re.astype(f32), b_im.astype(f32))
    bu_re = jnp.einsum('blgc,gpc->blgp', ug, bb_re)
    bu_im = jnp.einsum('blgc,gpc->blgp', ug, bb_im)
    h0r, h0i = h0_re.astype(f32), h0_im.astype(f32)
    first_re = ab_re * h0r - ab_im * h0i + bu_re[:, 0]
    first_im = ab_re * h0i + ab_im * h0r + bu_im[:, 0]
    bu_re = bu_re.at[:, 0].set(first_re)
    bu_im = bu_im.at[:, 0].set(first_im)
    a_re = jnp.broadcast_to(ab_re, bu_re.shape)
    a_im = jnp.broadcast_to(ab_im, bu_im.shape)
    _, _, h_re, h_im = lax.associative_scan(_cplx_affine_combine, (a_re, a_im, bu_re, bu_im), axis=1)
    y = (jnp.einsum('blgp,gcp->blgc', h_re, c_re.astype(f32))
         - jnp.einsum('blgp,gcp->blgc', h_im, c_im.astype(f32)))
    y = y.reshape(b, l, D_SSM) + d_skip.astype(f32) * uf
    return y.astype(u.dtype), h_re[:, -1], h_im[:, -1]


def hybrid_layer(x, attn_fn, h0_re, h0_im, g_mix, w_in, sinks, w_attn_o, lam_re, lam_im, log_dt,
                 b_re, b_im, c_re, c_im, d_skip, w_glu, w_out, g_ffn, w_up, w_down):
    b, l = x.shape[0], x.shape[1]
    h = rmsnorm(x, g_mix)
    proj = h @ w_in
    q, k, v, u, gate_logits = jnp.split(
        proj, [D_ATTN, D_ATTN + D_KV, D_ATTN + 2 * D_KV, D_ATTN + 2 * D_KV + D_SSM], axis=-1)
    q = q.reshape(b, l, N_HEADS, HEAD_DIM)
    k = k.reshape(b, l, N_KV_HEADS, HEAD_DIM)
    v = v.reshape(b, l, N_KV_HEADS, HEAD_DIM)
    attn, k_buf, v_buf = attn_fn(q, k, v, sinks)
    a_out = attn @ w_attn_o
    y_ssm, hT_re, hT_im = s5_branch(u, h0_re, h0_im, lam_re, lam_im, log_dt,
                                    b_re, b_im, c_re, c_im, d_skip)
    glu = jax.nn.gelu(y_ssm) @ w_glu
    s_out = glu[..., :D_MODEL] * jax.nn.sigmoid(glu[..., D_MODEL:])
    merged = (jax.nn.sigmoid(gate_logits[..., :D_MODEL]) * a_out
              + jax.nn.sigmoid(gate_logits[..., D_MODEL:]) * s_out)
    x = x + merged @ w_out
    h2 = rmsnorm(x, g_ffn)
    x = x + jnp.square(jax.nn.relu(h2 @ w_up)) @ w_down
    return x, k_buf, v_buf, hT_re, hT_im


def setup_inputs(seed: int = 0) -> dict:
    key = jax.random.key(seed)
    ks = jax.random.split(key, 24)
    f32 = jnp.float32
    nrm = lambda k, shape, scale: jax.random.normal(k, shape, f32) * scale
    lam_im_base = jnp.broadcast_to(math.pi * jnp.arange(SSM_STATE, dtype=f32), (DEPTH, SSM_GROUPS, SSM_STATE))
    return {
        "x_prompt": nrm(ks[0], (BATCH, SEQ, D_MODEL), 1.0),
        "x_sample": nrm(ks[1], (DEC_BATCH, DEC_SEQ, D_MODEL), 1.0),
        "cache_k": nrm(ks[2], (DEPTH, DEC_BATCH, WINDOW, N_KV_HEADS, HEAD_DIM), 1.0),
        "cache_v": nrm(ks[3], (DEPTH, DEC_BATCH, WINDOW, N_KV_HEADS, HEAD_DIM), 1.0),
        "state_ssm_re": nrm(ks[4], (DEPTH, DEC_BATCH, SSM_GROUPS, SSM_STATE), 0.5),
        "state_ssm_im": nrm(ks[5], (DEPTH, DEC_BATCH, SSM_GROUPS, SSM_STATE), 0.5),
        "g_mix": 1.0 + nrm(ks[6], (DEPTH, D_MODEL), 0.1),
        "w_in": nrm(ks[7], (DEPTH, D_MODEL, D_IN), D_MODEL ** -0.5),
        "attn_sinks": nrm(ks[8], (DEPTH, N_HEADS), 0.5),
        "w_attn_o": nrm(ks[9], (DEPTH, D_ATTN, D_MODEL), D_ATTN ** -0.5),
        "ssm_lambda_re": -0.5 + nrm(ks[10], (DEPTH, SSM_GROUPS, SSM_STATE), 0.01),
        "ssm_lambda_im": lam_im_base + nrm(ks[11], (DEPTH, SSM_GROUPS, SSM_STATE), 0.01),
        "ssm_log_dt": jax.random.uniform(ks[12], (DEPTH, SSM_GROUPS), f32,
                                         math.log(DT_MIN), math.log(DT_MAX)),
        "ssm_b_re": nrm(ks[13], (DEPTH, SSM_GROUPS, SSM_STATE, SSM_CH), (2 * SSM_CH) ** -0.5),
        "ssm_b_im": nrm(ks[14], (DEPTH, SSM_GROUPS, SSM_STATE, SSM_CH), (2 * SSM_CH) ** -0.5),
        "ssm_c_re": nrm(ks[15], (DEPTH, SSM_GROUPS, SSM_CH, SSM_STATE), (2 * SSM_STATE) ** -0.5),
        "ssm_c_im": nrm(ks[16], (DEPTH, SSM_GROUPS, SSM_CH, SSM_STATE), (2 * SSM_STATE) ** -0.5),
        "ssm_d": nrm(ks[17], (DEPTH, D_SSM), 1.0),
        "w_glu": nrm(ks[18], (DEPTH, D_SSM, 2 * D_MODEL), D_SSM ** -0.5),
        "w_out": nrm(ks[19], (DEPTH, D_MODEL, D_MODEL), D_MODEL ** -0.5),
        "g_ffn": 1.0 + nrm(ks[20], (DEPTH, D_MODEL), 0.1),
        "w_up": nrm(ks[21], (DEPTH, D_MODEL, D_FF), D_MODEL ** -0.5),
        "w_down": nrm(ks[22], (DEPTH, D_FF, D_MODEL), D_FF ** -0.5),
        "g_final": 1.0 + nrm(ks[23], (D_MODEL,), 0.1),
    }


def reference(x_prompt, x_sample, cache_k, cache_v, state_ssm_re, state_ssm_im, g_mix, w_in,
              attn_sinks, w_attn_o, ssm_lambda_re, ssm_lambda_im, ssm_log_dt, ssm_b_re, ssm_b_im,
              ssm_c_re, ssm_c_im, ssm_d, w_glu, w_out, g_ffn, w_up, w_down, g_final):
    yp, ys = x_prompt, x_sample
    kp_l, vp_l, hpr_l, hpi_l = [], [], [], []
    ksl, vsl, hsr_l, hsi_l = [], [], [], []
    h0_zero = jnp.zeros((x_prompt.shape[0], SSM_GROUPS, SSM_STATE), jnp.float32)
    for l in range(DEPTH):
        params = (g_mix[l], w_in[l], attn_sinks[l], w_attn_o[l], ssm_lambda_re[l], ssm_lambda_im[l],
                  ssm_log_dt[l], ssm_b_re[l], ssm_b_im[l], ssm_c_re[l], ssm_c_im[l], ssm_d[l],
                  w_glu[l], w_out[l], g_ffn[l], w_up[l], w_down[l])
        yp, kp, vp, hpr, hpi = hybrid_layer(yp, prompt_attention, h0_zero, h0_zero, *params)
        samp_fn = functools.partial(sample_attention, cache_k=cache_k[l], cache_v=cache_v[l])
        ys, kq, vq, hsr, hsi = hybrid_layer(ys, samp_fn, state_ssm_re[l], state_ssm_im[l], *params)
        kp_l.append(kp); vp_l.append(vp); hpr_l.append(hpr); hpi_l.append(hpi)
        ksl.append(kq); vsl.append(vq); hsr_l.append(hsr); hsi_l.append(hsi)
    y_prompt = rmsnorm(yp, g_final)
    y_sample = rmsnorm(ys, g_final)
    k_prompt = jnp.stack(kp_l, axis=0)
    v_prompt = jnp.stack(vp_l, axis=0)
    ssm_re_prompt = jnp.stack(hpr_l, axis=0)
    ssm_im_prompt = jnp.stack(hpi_l, axis=0)
    k_sample = jnp.stack(ksl, axis=0)
    v_sample = jnp.stack(vsl, axis=0)
    ssm_re_sample = jnp.stack(hsr_l, axis=0)
    ssm_im_sample = jnp.stack(hsi_l, axis=0)
    return (y_prompt, y_sample, k_prompt, v_prompt, ssm_re_prompt, ssm_im_prompt,
            k_sample, v_sample, ssm_re_sample, ssm_im_sample)
```

```cpp
#include <hip/hip_runtime.h>
#include <stdint.h>
#include <math.h>

constexpr int D = 1024, SEQ = 8192, NB = 2, DB = 128, DS = 4, PAST = 16384;
constexpr int MP = NB * SEQ;
constexpr int MS = DB * DS;
constexpr int M = MP + MS;
constexpr int HD = 64, NH = 16, NKV = 4, WIN = 128;
constexpr int DKV = NKV * HD;
constexpr int NG = 64, NCH = 16, NST = 64;
constexpr int DFF = 4096;
constexpr int DIN = 4608;
constexpr int CQ = 0, CK = 1024, CV = 1280, CU = 1536, CGA = 2560, CGS = 3584;
constexpr float EPS = 1e-5f;
constexpr float LOG2E = 1.4426950408889634f;
constexpr float C2 = 0.125f * LOG2E;

constexpr size_t O_Y = 0;
constexpr size_t O_KP = (size_t)M * D;
constexpr size_t O_VP = O_KP + (size_t)NB * WIN * DKV;
constexpr size_t O_HRP = O_VP + (size_t)NB * WIN * DKV;
constexpr size_t O_HIP = O_HRP + (size_t)NB * NG * NST;
constexpr size_t O_KS = O_HIP + (size_t)NB * NG * NST;
constexpr size_t O_VS = O_KS + (size_t)DB * WIN * DKV;
constexpr size_t O_HRS = O_VS + (size_t)DB * WIN * DKV;
constexpr size_t O_HIS = O_HRS + (size_t)DB * NG * NST;
constexpr size_t O_END = O_HIS + (size_t)DB * NG * NST;

constexpr size_t MiB = 1u << 20;
constexpr size_t WS_CTL = 0;
constexpr size_t WS_WIN = 1 * MiB;
constexpr size_t WS_WO = 10 * MiB;
constexpr size_t WS_WGLU = 12 * MiB;
constexpr size_t WS_WOUT = 16 * MiB;
constexpr size_t WS_WUP = 18 * MiB;
constexpr size_t WS_WDN = 26 * MiB;
constexpr size_t WS_XN = 34 * MiB;
constexpr size_t WS_P = 67 * MiB;
constexpr size_t WS_XN2 = 216 * MiB;
constexpr size_t WS_TAB = 249 * MiB;
constexpr size_t WS_RS = 250 * MiB;
constexpr size_t WS_END = 252 * MiB;
constexpr size_t TB_A = 0;
constexpr size_t TB_BB = TB_A + NG * NST * 2;
constexpr size_t TB_END = TB_BB + (size_t)NG * NST * NCH * 2;

typedef unsigned short bf16;
__device__ __forceinline__ bf16 f2bf(float f) { unsigned u = __builtin_bit_cast(unsigned, f); return (bf16)((u + 0x7fffu + ((u >> 16) & 1u)) >> 16); }
__device__ __forceinline__ float bf2f(bf16 h) { return __builtin_bit_cast(float, (unsigned)h << 16); }
__device__ __forceinline__ float sigmoidf_(float x) { return 1.f / (1.f + __expf(-x)); }
__device__ __forceinline__ float gelu_tanh(float x) { const float z = 0.7978845608028654f * (x + 0.044715f * x * x * x); return x / (1.f + __expf(-2.f * z)); }
__device__ __forceinline__ const float* xrow(const float* xp, const float* xs, int m) { return m < MP ? xp + (size_t)m * D : xs + (size_t)(m - MP) * D; }

__global__ void __launch_bounds__(256) k_prep_w(const float* __restrict__ W, const float* __restrict__ scale, bf16* __restrict__ Wt, int K, int N) {
    __shared__ float tile[32][33];
    const int k0 = blockIdx.y * 32, n0 = blockIdx.x * 32, tx = threadIdx.x & 31, ty = threadIdx.x >> 5;
    for (int i = ty; i < 32; i += 8) { const int k = k0 + i; tile[i][tx] = W[(size_t)k * N + n0 + tx] * (scale ? scale[k] : 1.f); }
    __syncthreads();
    for (int i = ty; i < 32; i += 8) Wt[(size_t)(n0 + i) * K + k0 + tx] = f2bf(tile[tx][i]);
}
__global__ void __launch_bounds__(256) k_xn(const float* __restrict__ xp, const float* __restrict__ xs, bf16* __restrict__ XN) {
    const int m = blockIdx.x * 4 + (threadIdx.x >> 6), lane = threadIdx.x & 63;
    if (m >= M) return;
    const float* x = xrow(xp, xs, m);
    float v[16]; float s = 0.f;
    _Pragma("unroll") for (int j = 0; j < 16; ++j) { v[j] = x[lane + 64 * j]; s += v[j] * v[j]; }
    for (int o = 1; o < 64; o <<= 1) s += __shfl_xor(s, o);
    const float r = rsqrtf(s * (1.f / D) + EPS);
    _Pragma("unroll") for (int j = 0; j < 16; ++j) XN[(size_t)m * D + lane + 64 * j] = f2bf(v[j] * r);
}
__global__ void __launch_bounds__(64) k_ssm_tab(const float* __restrict__ lre, const float* __restrict__ lim, const float* __restrict__ ldt,
                                                const float* __restrict__ bre, const float* __restrict__ bim, float* __restrict__ tab) {
    const int g = blockIdx.x, p = threadIdx.x;
    const double dt = exp((double)ldt[g]), lr = lre[g * NST + p], li = lim[g * NST + p];
    const double dec = exp(lr * dt), ar = dec * cos(li * dt), ai = dec * sin(li * dt);
    const double nr = ar - 1.0, ni = ai, den = lr * lr + li * li;
    const double fr = (nr * lr + ni * li) / den, fi = (ni * lr - nr * li) / den;
    tab[TB_A + (g * NST + p) * 2 + 0] = (float)ar; tab[TB_A + (g * NST + p) * 2 + 1] = (float)ai;
    _Pragma("unroll") for (int c = 0; c < NCH; ++c) {
        const double br = bre[(g * NST + p) * NCH + c], bi = bim[(g * NST + p) * NCH + c];
        tab[TB_BB + ((size_t)(g * NST + p) * NCH + c) * 2 + 0] = (float)(fr * br - fi * bi);
        tab[TB_BB + ((size_t)(g * NST + p) * NCH + c) * 2 + 1] = (float)(fr * bi + fi * br);
    }
}
struct EpiArgs { bf16* P; bf16* T; bf16* XN2; float* OUT; const float* xp; const float* xs; const float* rs; };
enum { MODE_G1 = 0, MODE_S1A, MODE_S1B, MODE_S1C, MODE_S2, MODE_S3, MODE_S4 };
template <int MODE> __device__ __forceinline__ void epi(const EpiArgs& e, int m, int n, float acc) {
    if (MODE == MODE_G1) { float v = acc; if (n < CK) v = acc * C2; else if (n >= CGA) v = sigmoidf_(acc); e.P[(size_t)m * DIN + n] = f2bf(v); }
    if (MODE == MODE_S1A) { e.T[(size_t)m * D + n] = f2bf(bf2f(e.P[(size_t)m * DIN + CGS + n]) * sigmoidf_(acc)); }
    if (MODE == MODE_S1B) { e.T[(size_t)m * D + n] = f2bf(acc * bf2f(e.T[(size_t)m * D + n])); }
    if (MODE == MODE_S1C) { e.T[(size_t)m * D + n] = f2bf(bf2f(e.P[(size_t)m * DIN + CGA + n]) * acc + bf2f(e.T[(size_t)m * D + n])); }
    if (MODE == MODE_S2) { const float x1 = xrow(e.xp, e.xs, m)[n] + acc; e.OUT[(size_t)m * D + n] = x1; e.XN2[(size_t)m * D + n] = f2bf(x1); }
    if (MODE == MODE_S3) { const float v = fmaxf(acc * e.rs[m], 0.f); e.P[(size_t)m * DIN + n] = f2bf(v * v); }
    if (MODE == MODE_S4) { e.OUT[(size_t)m * D + n] += acc; }
}
template <int MODE> __global__ void __launch_bounds__(256) k_gemm(const bf16* __restrict__ A, int lda, const bf16* __restrict__ Bt, int K, EpiArgs e) {
    __shared__ float As[64][33], Bs[64][33];
    const int m0 = blockIdx.y * 64, n0 = blockIdx.x * 64, tid = threadIdx.x, tx = tid & 15, ty = tid >> 4;
    float acc[4][4] = {};
    for (int k0 = 0; k0 < K; k0 += 32) {
        for (int i = tid; i < 64 * 32; i += 256) { const int r = i >> 5, c = i & 31; As[r][c] = bf2f(A[(size_t)(m0 + r) * lda + k0 + c]); Bs[r][c] = bf2f(Bt[(size_t)(n0 + r) * K + k0 + c]); }
        __syncthreads();
#pragma unroll 8
        for (int kk = 0; kk < 32; ++kk) {
            float a[4], b[4];
#pragma unroll
            for (int i = 0; i < 4; ++i) { a[i] = As[ty * 4 + i][kk]; b[i] = Bs[tx * 4 + i][kk]; }
#pragma unroll
            for (int i = 0; i < 4; ++i)
#pragma unroll
                for (int j = 0; j < 4; ++j) acc[i][j] += a[i] * b[j];
        }
        __syncthreads();
    }
#pragma unroll
    for (int i = 0; i < 4; ++i)
#pragma unroll
        for (int j = 0; j < 4; ++j) epi<MODE>(e, m0 + ty * 4 + i, n0 + tx * 4 + j, acc[i][j]);
}
__global__ void __launch_bounds__(64) k_attn(bf16* __restrict__ P, const float* __restrict__ ck, const float* __restrict__ cv, const float* __restrict__ sinks) {
    const int idx = blockIdx.x * 64 + threadIdx.x; if (idx >= M * NH) return;
    const int m = idx / NH, h = idx % NH, kvh = h / 4;
    float q[HD];
    _Pragma("unroll") for (int d = 0; d < HD; ++d) q[d] = bf2f(P[(size_t)m * DIN + CQ + h * HD + d]);
    const float sl = sinks[h] * LOG2E;
    float mx = sl, l = 1.f, o[HD];
    _Pragma("unroll") for (int d = 0; d < HD; ++d) o[d] = 0.f;
    const bool samp = m >= MP;
    const int db = samp ? (m - MP) / DS : 0, ts = samp ? (m - MP) % DS : 0, b = m / SEQ, t = m % SEQ;
    const int nk = samp ? WIN : (t + 1 < WIN ? t + 1 : WIN);
    for (int i = 0; i < nk; ++i) {
        float s = 0.f;
        const bf16* kp; const bf16* vp; const float* kf = nullptr; const float* vf = nullptr;
        if (!samp) { const size_t r = (size_t)(b * SEQ + t - nk + 1 + i) * DIN; kp = P + r + CK + kvh * HD; vp = P + r + CV + kvh * HD; }
        else { const int j = ts + 1 + i;
            if (j < WIN) { const size_t r = ((size_t)(db * WIN + j) * NKV + kvh) * HD; kf = ck + r; vf = cv + r; kp = vp = nullptr; }
            else { const size_t r = (size_t)(MP + db * DS + (j - WIN)) * DIN; kp = P + r + CK + kvh * HD; vp = P + r + CV + kvh * HD; } }
        _Pragma("unroll") for (int d = 0; d < HD; ++d) s += q[d] * (kf ? bf2f(f2bf(kf[d])) : bf2f(kp[d]));
        const float mn = fmaxf(mx, s), f = exp2f(mx - mn), pj = exp2f(s - mn);
        l = l * f + pj;
        _Pragma("unroll") for (int d = 0; d < HD; ++d) o[d] = o[d] * f + pj * (vf ? bf2f(f2bf(vf[d])) : bf2f(vp[d]));
        mx = mn;
    }
    const float il = 1.f / l;
    _Pragma("unroll") for (int d = 0; d < HD; ++d) P[(size_t)m * DIN + CQ + h * HD + d] = f2bf(o[d] * il);
}
__global__ void __launch_bounds__(64) k_ssm(bf16* __restrict__ P, const float* __restrict__ tab, const float* __restrict__ cre, const float* __restrict__ cim, const float* __restrict__ dsk,
                                            const float* __restrict__ h0r, const float* __restrict__ h0i, float* __restrict__ outr, float* __restrict__ outi, int row0, int ntok) {
    const int seq = blockIdx.x / NG, g = blockIdx.x % NG, p = threadIdx.x;
    const float ar = tab[TB_A + (g * NST + p) * 2], ai = tab[TB_A + (g * NST + p) * 2 + 1];
    float br[NCH], bi[NCH], cr[NCH], ci[NCH];
    _Pragma("unroll") for (int c = 0; c < NCH; ++c) { br[c] = tab[TB_BB + ((size_t)(g * NST + p) * NCH + c) * 2]; bi[c] = tab[TB_BB + ((size_t)(g * NST + p) * NCH + c) * 2 + 1];
        cr[c] = cre[(g * NCH + c) * NST + p]; ci[c] = cim[(g * NCH + c) * NST + p]; }
    float hr = h0r ? h0r[((size_t)seq * NG + g) * NST + p] : 0.f, hi = h0i ? h0i[((size_t)seq * NG + g) * NST + p] : 0.f;
    const float dv = dsk[g * NCH + (p & 15)];
    for (int t = 0; t < ntok; ++t) {
        bf16* urow = P + (size_t)(row0 + seq * ntok + t) * DIN + CU + g * NCH;
        float u[NCH]; float sr = 0.f, si = 0.f;
        _Pragma("unroll") for (int c = 0; c < NCH; ++c) { u[c] = bf2f(urow[c]); sr += br[c] * u[c]; si += bi[c] * u[c]; }
        const float nr = ar * hr - ai * hi + sr, ni = ar * hi + ai * hr + si; hr = nr; hi = ni;
        float y = 0.f, up = 0.f;
        _Pragma("unroll") for (int c = 0; c < NCH; ++c) { float v = cr[c] * hr - ci[c] * hi; for (int o = 1; o < 64; o <<= 1) v += __shfl_xor(v, o); if ((p & 15) == c) { y = v; up = u[c]; } }
        if (p < NCH) { const float yy = y + dv * up; urow[p] = f2bf(gelu_tanh(yy)); }
    }
    outr[((size_t)seq * NG + g) * NST + p] = hr; outi[((size_t)seq * NG + g) * NST + p] = hi;
}
__global__ void __launch_bounds__(256) k_kvout(const bf16* __restrict__ P, const float* __restrict__ ck, const float* __restrict__ cv, float* __restrict__ out) {
    const size_t i = (size_t)blockIdx.x * 256 + threadIdx.x;
    const size_t NP = (size_t)NB * WIN * DKV, NS = (size_t)DB * WIN * DKV;
    if (i < NP) { const int c = i % DKV, j = (i / DKV) % WIN, b = i / ((size_t)DKV * WIN); const size_t r = (size_t)(b * SEQ + SEQ - WIN + j) * DIN;
        out[O_KP + i] = bf2f(P[r + CK + c]); out[O_VP + i] = bf2f(P[r + CV + c]); }
    else if (i < NP + NS) { const size_t k = i - NP; const int c = k % DKV, j = (k / DKV) % WIN, db = k / ((size_t)DKV * WIN);
        if (j < WIN - DS) { out[O_KS + k] = ck[((size_t)db * WIN + j + DS) * DKV + c]; out[O_VS + k] = cv[((size_t)db * WIN + j + DS) * DKV + c]; }
        else { const size_t r = (size_t)(MP + db * DS + (j - (WIN - DS))) * DIN; out[O_KS + k] = bf2f(P[r + CK + c]); out[O_VS + k] = bf2f(P[r + CV + c]); } }
}
__global__ void __launch_bounds__(256) k_rowrs(const float* __restrict__ OUT, float* __restrict__ rs) {
    const int m = blockIdx.x * 4 + (threadIdx.x >> 6), lane = threadIdx.x & 63; if (m >= M) return;
    float s = 0.f; _Pragma("unroll") for (int j = 0; j < 16; ++j) { const float v = OUT[(size_t)m * D + lane + 64 * j]; s += v * v; }
    for (int o = 1; o < 64; o <<= 1) s += __shfl_xor(s, o);
    if (lane == 0) rs[m] = rsqrtf(s * (1.f / D) + EPS);
}
__global__ void __launch_bounds__(256) k_final(float* __restrict__ OUT, const float* __restrict__ g) {
    const int m = blockIdx.x * 4 + (threadIdx.x >> 6), lane = threadIdx.x & 63; if (m >= M) return;
    float v[16]; float s = 0.f; _Pragma("unroll") for (int j = 0; j < 16; ++j) { v[j] = OUT[(size_t)m * D + lane + 64 * j]; s += v[j] * v[j]; }
    for (int o = 1; o < 64; o <<= 1) s += __shfl_xor(s, o);
    const float r = rsqrtf(s * (1.f / D) + EPS);
    _Pragma("unroll") for (int j = 0; j < 16; ++j) OUT[(size_t)m * D + lane + 64 * j] = v[j] * r * g[lane + 64 * j];
}

extern "C" void kernel_launch(void* const* d_in, const int* in_sizes, int n_in, void* d_out, int out_size, void* d_ws, size_t ws_size, hipStream_t stream) {
    if (n_in != 24 || (size_t)out_size != O_END || ws_size < WS_END) return;
    const float* xp = (const float*)d_in[0]; const float* xs = (const float*)d_in[1];
    const float* ck = (const float*)d_in[2]; const float* cv = (const float*)d_in[3];
    const float* s0r = (const float*)d_in[4]; const float* s0i = (const float*)d_in[5];
    const float* g_mix = (const float*)d_in[6]; const float* w_in = (const float*)d_in[7]; const float* sinks = (const float*)d_in[8];
    const float* w_ao = (const float*)d_in[9]; const float* lre = (const float*)d_in[10]; const float* lim = (const float*)d_in[11]; const float* ldt = (const float*)d_in[12];
    const float* bre = (const float*)d_in[13]; const float* bim = (const float*)d_in[14]; const float* cre = (const float*)d_in[15]; const float* cim = (const float*)d_in[16];
    const float* dsk = (const float*)d_in[17]; const float* w_glu = (const float*)d_in[18]; const float* w_out = (const float*)d_in[19]; const float* g_ffn = (const float*)d_in[20];
    const float* w_up = (const float*)d_in[21]; const float* w_dn = (const float*)d_in[22]; const float* g_fin = (const float*)d_in[23];
    unsigned char* ws = (unsigned char*)d_ws; float* out = (float*)d_out;
    bf16* Wi = (bf16*)(ws + WS_WIN); bf16* Wo = (bf16*)(ws + WS_WO); bf16* Wg = (bf16*)(ws + WS_WGLU); bf16* Wu = (bf16*)(ws + WS_WOUT); bf16* Wp = (bf16*)(ws + WS_WUP); bf16* Wd = (bf16*)(ws + WS_WDN);
    bf16* XN = (bf16*)(ws + WS_XN); bf16* P = (bf16*)(ws + WS_P); bf16* XN2 = (bf16*)(ws + WS_XN2); float* tab = (float*)(ws + WS_TAB); float* rs = (float*)(ws + WS_RS);
    bf16* T = XN;
    k_prep_w<<<dim3(DIN / 32, D / 32), 256, 0, stream>>>(w_in, g_mix, Wi, D, DIN);
    k_prep_w<<<dim3(D / 32, D / 32), 256, 0, stream>>>(w_ao, nullptr, Wo, D, D);
    k_prep_w<<<dim3(2 * D / 32, D / 32), 256, 0, stream>>>(w_glu, nullptr, Wg, D, 2 * D);
    k_prep_w<<<dim3(D / 32, D / 32), 256, 0, stream>>>(w_out, nullptr, Wu, D, D);
    k_prep_w<<<dim3(DFF / 32, D / 32), 256, 0, stream>>>(w_up, g_ffn, Wp, D, DFF);
    k_prep_w<<<dim3(D / 32, DFF / 32), 256, 0, stream>>>(w_dn, nullptr, Wd, DFF, D);
    k_xn<<<M / 4, 256, 0, stream>>>(xp, xs, XN);
    k_ssm_tab<<<NG, 64, 0, stream>>>(lre, lim, ldt, bre, bim, tab);
    EpiArgs e{P, T, XN2, out, xp, xs, rs};
    k_gemm<MODE_G1><<<dim3(DIN / 64, M / 64), 256, 0, stream>>>(XN, D, Wi, D, e);
    k_kvout<<<(unsigned)(((size_t)NB * WIN * DKV + (size_t)DB * WIN * DKV + 255) / 256), 256, 0, stream>>>(P, ck, cv, out);
    k_attn<<<M * NH / 64, 64, 0, stream>>>(P, ck, cv, sinks);
    k_ssm<<<NB * NG, 64, 0, stream>>>(P, tab, cre, cim, dsk, nullptr, nullptr, out + O_HRP, out + O_HIP, 0, SEQ);
    k_ssm<<<DB * NG, 64, 0, stream>>>(P, tab, cre, cim, dsk, s0r, s0i, out + O_HRS, out + O_HIS, MP, DS);
    k_gemm<MODE_S1A><<<dim3(D / 64, M / 64), 256, 0, stream>>>(P + CU, DIN, Wg + (size_t)D * D, D, e);
    k_gemm<MODE_S1B><<<dim3(D / 64, M / 64), 256, 0, stream>>>(P + CU, DIN, Wg, D, e);
    k_gemm<MODE_S1C><<<dim3(D / 64, M / 64), 256, 0, stream>>>(P + CQ, DIN, Wo, D, e);
    k_gemm<MODE_S2><<<dim3(D / 64, M / 64), 256, 0, stream>>>(T, D, Wu, D, e);
    k_rowrs<<<M / 4, 256, 0, stream>>>(out, rs);
    k_gemm<MODE_S3><<<dim3(DFF / 64, M / 64), 256, 0, stream>>>(XN2, D, Wp, D, e);
    k_gemm<MODE_S4><<<dim3(D / 64, M / 64), 256, 0, stream>>>(P, DIN, Wd, DFF, e);
    k_final<<<M / 4, 256, 0, stream>>>(out, g_fin);
}
```

```cpp
#include <hip/hip_runtime.h>
#include <stdint.h>
#include <math.h>

constexpr int D = 1024, SEQ = 8192, NB = 2, DB = 128, DS = 4, PAST = 16384;
constexpr int MP = NB * SEQ;
constexpr int MS = DB * DS;
constexpr int M = MP + MS;
constexpr int HD = 64, NH = 16, NKV = 4, WIN = 128;
constexpr int DKV = NKV * HD;
constexpr int NG = 64, NCH = 16, NST = 64;
constexpr int DFF = 4096;
constexpr int DIN = 4608;
constexpr int CQ = 0, CK = 1024, CV = 1280, CU = 1536, CGA = 2560, CGS = 3584;
constexpr float EPS = 1e-5f;
constexpr float LOG2E = 1.4426950408889634f;
constexpr float C2 = 0.125f * LOG2E;

constexpr size_t O_Y = 0;
constexpr size_t O_KP = (size_t)M * D;
constexpr size_t O_VP = O_KP + (size_t)NB * WIN * DKV;
constexpr size_t O_HRP = O_VP + (size_t)NB * WIN * DKV;
constexpr size_t O_HIP = O_HRP + (size_t)NB * NG * NST;
constexpr size_t O_KS = O_HIP + (size_t)NB * NG * NST;
constexpr size_t O_VS = O_KS + (size_t)DB * WIN * DKV;
constexpr size_t O_HRS = O_VS + (size_t)DB * WIN * DKV;
constexpr size_t O_HIS = O_HRS + (size_t)DB * NG * NST;
constexpr size_t O_END = O_HIS + (size_t)DB * NG * NST;

constexpr size_t MiB = 1u << 20;
constexpr size_t WS_CTL = 0;
constexpr size_t WS_WIN = 1 * MiB;
constexpr size_t WS_WO = 10 * MiB;
constexpr size_t WS_WGLU = 12 * MiB;
constexpr size_t WS_WOUT = 16 * MiB;
constexpr size_t WS_WUP = 18 * MiB;
constexpr size_t WS_WDN = 26 * MiB;
constexpr size_t WS_XN = 34 * MiB;
constexpr size_t WS_P = 67 * MiB;
constexpr size_t WS_XN2 = 216 * MiB;
constexpr size_t WS_TAB = 249 * MiB;
constexpr size_t WS_RS = 250 * MiB;
constexpr size_t WS_END = 253 * MiB;
constexpr size_t TB_A = 0;
constexpr size_t TB_BB = TB_A + NG * NST * 2;
constexpr size_t TB_END = TB_BB + (size_t)NG * NST * NCH * 2;

typedef unsigned short bf16;
__device__ __forceinline__ bf16 f2bf(float f) { unsigned u = __builtin_bit_cast(unsigned, f); return (bf16)((u + 0x7fffu + ((u >> 16) & 1u)) >> 16); }
__device__ __forceinline__ float bf2f(bf16 h) { return __builtin_bit_cast(float, (unsigned)h << 16); }
__device__ __forceinline__ float sigmoidf_(float x) { return 1.f / (1.f + __expf(-x)); }
__device__ __forceinline__ float gelu_tanh(float x) { const float z = 0.7978845608028654f * (x + 0.044715f * x * x * x); return x / (1.f + __expf(-2.f * z)); }
__device__ __forceinline__ const float* xrow(const float* xp, const float* xs, int m) { return m < MP ? xp + (size_t)m * D : xs + (size_t)(m - MP) * D; }

__global__ void __launch_bounds__(256) k_prep_w(const float* __restrict__ W, const float* __restrict__ scale, bf16* __restrict__ Wt, int K, int N) {
    __shared__ float tile[32][33];
    const int k0 = blockIdx.y * 32, n0 = blockIdx.x * 32, tx = threadIdx.x & 31, ty = threadIdx.x >> 5;
    for (int i = ty; i < 32; i += 8) { const int k = k0 + i; tile[i][tx] = W[(size_t)k * N + n0 + tx] * (scale ? scale[k] : 1.f); }
    __syncthreads();
    for (int i = ty; i < 32; i += 8) Wt[(size_t)(n0 + i) * K + k0 + tx] = f2bf(tile[tx][i]);
}
__global__ void __launch_bounds__(256) k_xn(const float* __restrict__ xp, const float* __restrict__ xs, bf16* __restrict__ XN) {
    const int m = blockIdx.x * 4 + (threadIdx.x >> 6), lane = threadIdx.x & 63;
    if (m >= M) return;
    const float* x = xrow(xp, xs, m);
    float v[16]; float s = 0.f;
    _Pragma("unroll") for (int j = 0; j < 16; ++j) { v[j] = x[lane + 64 * j]; s += v[j] * v[j]; }
    for (int o = 1; o < 64; o <<= 1) s += __shfl_xor(s, o);
    const float r = rsqrtf(s * (1.f / D) + EPS);
    _Pragma("unroll") for (int j = 0; j < 16; ++j) XN[(size_t)m * D + lane + 64 * j] = f2bf(v[j] * r);
}
__global__ void __launch_bounds__(64) k_ssm_tab(const float* __restrict__ lre, const float* __restrict__ lim, const float* __restrict__ ldt,
                                                const float* __restrict__ bre, const float* __restrict__ bim, float* __restrict__ tab) {
    const int g = blockIdx.x, p = threadIdx.x;
    const double dt = exp((double)ldt[g]), lr = lre[g * NST + p], li = lim[g * NST + p];
    const double dec = exp(lr * dt), ar = dec * cos(li * dt), ai = dec * sin(li * dt);
    const double nr = ar - 1.0, ni = ai, den = lr * lr + li * li;
    const double fr = (nr * lr + ni * li) / den, fi = (ni * lr - nr * li) / den;
    tab[TB_A + (g * NST + p) * 2 + 0] = (float)ar; tab[TB_A + (g * NST + p) * 2 + 1] = (float)ai;
    _Pragma("unroll") for (int c = 0; c < NCH; ++c) {
        const double br = bre[(g * NST + p) * NCH + c], bi = bim[(g * NST + p) * NCH + c];
        tab[TB_BB + ((size_t)(g * NST + p) * NCH + c) * 2 + 0] = (float)(fr * br - fi * bi);
        tab[TB_BB + ((size_t)(g * NST + p) * NCH + c) * 2 + 1] = (float)(fr * bi + fi * br);
    }
}
struct EpiArgs { bf16* P; bf16* T; bf16* XN2; float* OUT; const float* xp; const float* xs; const float* rs; };
enum { MODE_G1 = 0, MODE_S1A, MODE_S1B, MODE_S1C, MODE_S2, MODE_S3, MODE_S4 };
template <int MODE> __device__ __forceinline__ void epi(const EpiArgs& e, int m, int n, float acc) {
    if (MODE == MODE_G1) { float v = acc; if (n < CK) v = acc * C2; else if (n >= CGA) v = sigmoidf_(acc); e.P[(size_t)m * DIN + n] = f2bf(v); }
    if (MODE == MODE_S1A) { e.T[(size_t)m * D + n] = f2bf(bf2f(e.P[(size_t)m * DIN + CGS + n]) * sigmoidf_(acc)); }
    if (MODE == MODE_S1B) { e.T[(size_t)m * D + n] = f2bf(acc * bf2f(e.T[(size_t)m * D + n])); }
    if (MODE == MODE_S1C) { e.T[(size_t)m * D + n] = f2bf(bf2f(e.P[(size_t)m * DIN + CGA + n]) * acc + bf2f(e.T[(size_t)m * D + n])); }
    if (MODE == MODE_S2) { const float x1 = xrow(e.xp, e.xs, m)[n] + acc; e.OUT[(size_t)m * D + n] = x1; e.XN2[(size_t)m * D + n] = f2bf(x1); }
    if (MODE == MODE_S3) { const float v = fmaxf(acc * e.rs[m], 0.f); e.P[(size_t)m * DIN + n] = f2bf(v * v); }
    if (MODE == MODE_S4) { e.OUT[(size_t)m * D + n] += acc; }
}
template <int MODE> __global__ void __launch_bounds__(256) k_gemm(const bf16* __restrict__ A, int lda, const bf16* __restrict__ Bt, int K, EpiArgs e) {
    __shared__ float As[64][33], Bs[64][33];
    const int m0 = blockIdx.y * 64, n0 = blockIdx.x * 64, tid = threadIdx.x, tx = tid & 15, ty = tid >> 4;
    float acc[4][4] = {};
    for (int k0 = 0; k0 < K; k0 += 32) {
        for (int i = tid; i < 64 * 32; i += 256) { const int r = i >> 5, c = i & 31; As[r][c] = bf2f(A[(size_t)(m0 + r) * lda + k0 + c]); Bs[r][c] = bf2f(Bt[(size_t)(n0 + r) * K + k0 + c]); }
        __syncthreads();
#pragma unroll 8
        for (int kk = 0; kk < 32; ++kk) {
            float a[4], b[4];
#pragma unroll
            for (int i = 0; i < 4; ++i) { a[i] = As[ty * 4 + i][kk]; b[i] = Bs[tx * 4 + i][kk]; }
#pragma unroll
            for (int i = 0; i < 4; ++i)
#pragma unroll
                for (int j = 0; j < 4; ++j) acc[i][j] += a[i] * b[j];
        }
        __syncthreads();
    }
#pragma unroll
    for (int i = 0; i < 4; ++i)
#pragma unroll
        for (int j = 0; j < 4; ++j) epi<MODE>(e, m0 + ty * 4 + i, n0 + tx * 4 + j, acc[i][j]);
}
__global__ void __launch_bounds__(64) k_attn(bf16* __restrict__ P, const float* __restrict__ ck, const float* __restrict__ cv, const float* __restrict__ sinks) {
    const int idx = blockIdx.x * 64 + threadIdx.x; if (idx >= M * NH) return;
    const int m = idx / NH, h = idx % NH, kvh = h / 4;
    float q[HD];
    _Pragma("unroll") for (int d = 0; d < HD; ++d) q[d] = bf2f(P[(size_t)m * DIN + CQ + h * HD + d]);
    const float sl = sinks[h] * LOG2E;
    float mx = sl, l = 1.f, o[HD];
    _Pragma("unroll") for (int d = 0; d < HD; ++d) o[d] = 0.f;
    const bool samp = m >= MP;
    const int db = samp ? (m - MP) / DS : 0, ts = samp ? (m - MP) % DS : 0, b = m / SEQ, t = m % SEQ;
    const int nk = samp ? WIN : (t + 1 < WIN ? t + 1 : WIN);
    for (int i = 0; i < nk; ++i) {
        float s = 0.f;
        const bf16* kp; const bf16* vp; const float* kf = nullptr; const float* vf = nullptr;
        if (!samp) { const size_t r = (size_t)(b * SEQ + t - nk + 1 + i) * DIN; kp = P + r + CK + kvh * HD; vp = P + r + CV + kvh * HD; }
        else { const int j = ts + 1 + i;
            if (j < WIN) { const size_t r = ((size_t)(db * WIN + j) * NKV + kvh) * HD; kf = ck + r; vf = cv + r; kp = vp = nullptr; }
            else { const size_t r = (size_t)(MP + db * DS + (j - WIN)) * DIN; kp = P + r + CK + kvh * HD; vp = P + r + CV + kvh * HD; } }
        _Pragma("unroll") for (int d = 0; d < HD; ++d) s += q[d] * (kf ? bf2f(f2bf(kf[d])) : bf2f(kp[d]));
        const float mn = fmaxf(mx, s), f = exp2f(mx - mn), pj = exp2f(s - mn);
        l = l * f + pj;
        _Pragma("unroll") for (int d = 0; d < HD; ++d) o[d] = o[d] * f + pj * (vf ? bf2f(f2bf(vf[d])) : bf2f(vp[d]));
        mx = mn;
    }
    const float il = 1.f / l;
    _Pragma("unroll") for (int d = 0; d < HD; ++d) P[(size_t)m * DIN + CQ + h * HD + d] = f2bf(o[d] * il);
}
__global__ void __launch_bounds__(64) k_ssm(bf16* __restrict__ P, const float* __restrict__ tab, const float* __restrict__ cre, const float* __restrict__ cim, const float* __restrict__ dsk,
                                            const float* __restrict__ h0r, const float* __restrict__ h0i, float* __restrict__ outr, float* __restrict__ outi, int row0, int ntok) {
    const int seq = blockIdx.x / NG, g = blockIdx.x % NG, p = threadIdx.x;
    const float ar = tab[TB_A + (g * NST + p) * 2], ai = tab[TB_A + (g * NST + p) * 2 + 1];
    float br[NCH], bi[NCH], cr[NCH], ci[NCH];
    _Pragma("unroll") for (int c = 0; c < NCH; ++c) { br[c] = tab[TB_BB + ((size_t)(g * NST + p) * NCH + c) * 2]; bi[c] = tab[TB_BB + ((size_t)(g * NST + p) * NCH + c) * 2 + 1];
        cr[c] = cre[(g * NCH + c) * NST + p]; ci[c] = cim[(g * NCH + c) * NST + p]; }
    float hr = h0r ? h0r[((size_t)seq * NG + g) * NST + p] : 0.f, hi = h0i ? h0i[((size_t)seq * NG + g) * NST + p] : 0.f;
    const float dv = dsk[g * NCH + (p & 15)];
    for (int t = 0; t < ntok; ++t) {
        bf16* urow = P + (size_t)(row0 + seq * ntok + t) * DIN + CU + g * NCH;
        float u[NCH]; float sr = 0.f, si = 0.f;
        _Pragma("unroll") for (int c = 0; c < NCH; ++c) { u[c] = bf2f(urow[c]); sr += br[c] * u[c]; si += bi[c] * u[c]; }
        const float nr = ar * hr - ai * hi + sr, ni = ar * hi + ai * hr + si; hr = nr; hi = ni;
        float y = 0.f, up = 0.f;
        _Pragma("unroll") for (int c = 0; c < NCH; ++c) { float v = cr[c] * hr - ci[c] * hi; for (int o = 1; o < 64; o <<= 1) v += __shfl_xor(v, o); if ((p & 15) == c) { y = v; up = u[c]; } }
        if (p < NCH) { const float yy = y + dv * up; urow[p] = f2bf(gelu_tanh(yy)); }
    }
    outr[((size_t)seq * NG + g) * NST + p] = hr; outi[((size_t)seq * NG + g) * NST + p] = hi;
}
__global__ void __launch_bounds__(256) k_kvout(const bf16* __restrict__ P, const float* __restrict__ ck, const float* __restrict__ cv, float* __restrict__ out) {
    const size_t i = (size_t)blockIdx.x * 256 + threadIdx.x;
    const size_t NP = (size_t)NB * WIN * DKV, NS = (size_t)DB * WIN * DKV;
    if (i < NP) { const int c = i % DKV, j = (i / DKV) % WIN, b = i / ((size_t)DKV * WIN); const size_t r = (size_t)(b * SEQ + SEQ - WIN + j) * DIN;
        out[O_KP + i] = bf2f(P[r + CK + c]); out[O_VP + i] = bf2f(P[r + CV + c]); }
    else if (i < NP + NS) { const size_t k = i - NP; const int c = k % DKV, j = (k / DKV) % WIN, db = k / ((size_t)DKV * WIN);
        if (j < WIN - DS) { out[O_KS + k] = ck[((size_t)db * WIN + j + DS) * DKV + c]; out[O_VS + k] = cv[((size_t)db * WIN + j + DS) * DKV + c]; }
        else { const size_t r = (size_t)(MP + db * DS + (j - (WIN - DS))) * DIN; out[O_KS + k] = bf2f(P[r + CK + c]); out[O_VS + k] = bf2f(P[r + CV + c]); } }
}
__global__ void __launch_bounds__(256) k_rowrs(const float* __restrict__ OUT, float* __restrict__ rs) {
    const int m = blockIdx.x * 4 + (threadIdx.x >> 6), lane = threadIdx.x & 63; if (m >= M) return;
    float s = 0.f; _Pragma("unroll") for (int j = 0; j < 16; ++j) { const float v = OUT[(size_t)m * D + lane + 64 * j]; s += v * v; }
    for (int o = 1; o < 64; o <<= 1) s += __shfl_xor(s, o);
    if (lane == 0) rs[m] = rsqrtf(s * (1.f / D) + EPS);
}
__global__ void __launch_bounds__(256) k_final(float* __restrict__ OUT, const float* __restrict__ g) {
    const int m = blockIdx.x * 4 + (threadIdx.x >> 6), lane = threadIdx.x & 63; if (m >= M) return;
    float v[16]; float s = 0.f; _Pragma("unroll") for (int j = 0; j < 16; ++j) { v[j] = OUT[(size_t)m * D + lane + 64 * j]; s += v[j] * v[j]; }
    for (int o = 1; o < 64; o <<= 1) s += __shfl_xor(s, o);
    const float r = rsqrtf(s * (1.f / D) + EPS);
    _Pragma("unroll") for (int j = 0; j < 16; ++j) OUT[(size_t)m * D + lane + 64 * j] = v[j] * r * g[lane + 64 * j];
}

namespace pg8 {
#define PG8_LAS __attribute__((address_space(3)))
typedef short bf16x8 __attribute__((ext_vector_type(8)));
typedef float f32x4 __attribute__((ext_vector_type(4)));
typedef float f32x2 __attribute__((ext_vector_type(2)));
typedef unsigned u32x4 __attribute__((ext_vector_type(4)));
typedef unsigned u32x2 __attribute__((ext_vector_type(2)));
constexpr int BM = 256, BK = 64, HALF = 128, HTB = HALF * BK * 2, STAGE_BYTES = 8 * HTB, NXCD = 8, WGM = 8;
__host__ __device__ __forceinline__ int lds_byte(int r, int c) { const int st = (r >> 4) * 2 + (c >> 5), rr = r & 15, cc = c & 31, ob = rr * 64 + cc * 2; return st * 1024 + (ob ^ (((ob >> 9) & 1) << 5)); }
__host__ __device__ __forceinline__ void stage_rc(int b, int& R, int& C) { const int st = b / 1024, sb = b % 1024, swz = sb ^ (((sb >> 9) & 1) << 5); R = (st >> 1) * 16 + swz / 64; C = (st & 1) * 32 + (swz % 64) / 2; }
__host__ __device__ __forceinline__ int perm32(int rho) { const int n = rho >> 4, i = rho & 15; return 8 * (i >> 2) + 4 * n + (i & 3); }

struct Unit { int pm, pn; const char* A; const char* B; int mode; };
struct Geo { int lda; int K; };

struct TileOrder {
    int nM, nN, nwg, G, c;
    __device__ void init(int nM_, int nN_, int G_, int c_) { nM = nM_; nN = nN_; nwg = nM * nN; G = G_; c = c_; }
    __device__ bool tile(int i, int& pm, int& pn) const {
        const long L = (long)i * G + c; if (L >= nwg) return false;
        int wgid = (int)L; { const int q = nwg / NXCD, r = nwg % NXCD, xcd = wgid % NXCD, off = wgid / NXCD; wgid = (xcd < r ? xcd * (q + 1) : r * (q + 1) + (xcd - r) * q) + off; }
        const int nig = WGM * nN, gid = wgid / nig, fm = gid * WGM, gsz = (nM - fm) < WGM ? (nM - fm) : WGM;
        pm = fm + ((wgid % nig) % gsz); pn = (wgid % nig) / gsz; return true;
    }
};

__device__ __forceinline__ unsigned cvt_pk_bf16(float lo, float hi) { unsigned r; asm volatile("v_cvt_pk_bf16_f32 %0, %1, %2" : "=v"(r) : "v"(lo), "v"(hi)); return r; }
__device__ __forceinline__ float bflo(unsigned w) { return __builtin_bit_cast(float, w << 16); }
__device__ __forceinline__ float bfhi(unsigned w) { return __builtin_bit_cast(float, w & 0xffff0000u); }
__device__ __forceinline__ float fsig(float x) { return __builtin_amdgcn_rcpf(1.f + __builtin_amdgcn_exp2f(-1.4426950408889634f * x)); }

template <class Epi, class Sched, bool ALIGN_EPI, bool SP2>
__device__ __forceinline__ void gemm_phase(PG8_LAS unsigned char* lds, const Geo g, const Sched& S, const Epi& E) {
    const int tid = threadIdx.x, wid = __builtin_amdgcn_readfirstlane(tid >> 6), lane = tid & 63, wr = wid >> 2, wc = wid & 3, fr = lane & 15, fq = lane >> 4;
    const int K = g.K, nt = K / BK;
    unsigned voffA[2], voffB[2];
#pragma unroll
    for (int i = 0; i < 2; ++i) { int R, C; stage_rc(tid * 16 + i * 8192, R, C); const int Rb = (R & ~31) + perm32(R & 31);
        voffA[i] = (unsigned)(R * g.lda + C) * 2u; voffB[i] = (unsigned)(Rb * K + C) * 2u; }
    const size_t kstep = (size_t)(BK * 2);
    const size_t hA = (size_t)HALF * g.lda * 2, hB = (size_t)HALF * K * 2;
    const unsigned ldsw = (unsigned)wid * 1024u;
    const int aoff = lds_byte(wr * 64 + fr, fq * 8), boff = lds_byte(wc * 32 + fr, fq * 8);
#define PG8_SA(b, h) (((b) * 2 + (h)) * HTB)
#define PG8_SB(b, h) ((4 + (b) * 2 + (h)) * HTB)
#define PG8_STAGE(bufoff, gbase, voff) do { _Pragma("unroll") for (int _i = 0; _i < 2; ++_i) \
        __builtin_amdgcn_global_load_lds((const unsigned*)((const char*)(gbase) + (voff)[_i]), (PG8_LAS unsigned*)(lds + (bufoff) + ldsw + _i * 8192), 16, 0, 0); } while (0)
#define PG8_LDA(dst, b, h) do { _Pragma("unroll") for (int m = 0; m < 4; ++m) _Pragma("unroll") for (int k = 0; k < 2; ++k) dst[m][k] = *(const PG8_LAS bf16x8*)(lds + PG8_SA(b, h) + aoff + m * 2048 + k * 1024); } while (0)
#define PG8_LDB(dst, b, h) do { _Pragma("unroll") for (int n = 0; n < 2; ++n) _Pragma("unroll") for (int k = 0; k < 2; ++k) dst[n][k] = *(const PG8_LAS bf16x8*)(lds + PG8_SB(b, h) + boff + n * 2048 + k * 1024); } while (0)
#define PG8_MMA(ai, bj, At, Bt) do { __builtin_amdgcn_s_setprio(1); _Pragma("unroll") for (int m = 0; m < 4; ++m) _Pragma("unroll") for (int n = 0; n < 2; ++n) _Pragma("unroll") for (int k = 0; k < 2; ++k) \
        acc[ai][bj][m][n] = __builtin_amdgcn_mfma_f32_16x16x32_bf16(Bt[n][k], At[m][k], acc[ai][bj][m][n], 0, 0, 0); __builtin_amdgcn_s_setprio(0); } while (0)
#define PG8_WAIT_V(n) asm volatile("s_waitcnt vmcnt(" #n ")" ::: "memory")
#define PG8_WAIT_L(n) asm volatile("s_waitcnt lgkmcnt(" #n ")" ::: "memory")
#define PG8_BAR __builtin_amdgcn_s_barrier()
#define PG8_SCHED __builtin_amdgcn_sched_barrier(0)
    Unit cur, nxt; int ui = 0;
    if (!S.next(0, cur)) return;
    f32x4 acc[2][2][4][2];
#pragma unroll
    for (int a = 0; a < 2; ++a)
#pragma unroll
        for (int b = 0; b < 2; ++b)
#pragma unroll
            for (int m = 0; m < 4; ++m)
#pragma unroll
                for (int n = 0; n < 2; ++n) acc[a][b][m][n] = (f32x4){0.f, 0.f, 0.f, 0.f};
    bf16x8 At[4][2], B0[2][2], B1[2][2];
    const char* cA = cur.A; const char* cB = cur.B;
    S.a_ready(cur);
    if constexpr (SP2) {
        PG8_STAGE(PG8_SB(0, 0), cB, voffB); PG8_STAGE(PG8_SB(0, 1), cB + hB, voffB); PG8_STAGE(PG8_SA(0, 0), cA, voffA); PG8_STAGE(PG8_SA(0, 1), cA + hA, voffA);
        if (wr == 1) PG8_BAR;
        PG8_WAIT_V(2); PG8_BAR;
        PG8_STAGE(PG8_SB(1, 0), cB + kstep, voffB); PG8_STAGE(PG8_SA(1, 0), cA + kstep, voffA); PG8_STAGE(PG8_SB(1, 1), cB + hB + kstep, voffB);
        PG8_WAIT_V(6); PG8_BAR;
    } else {
        PG8_STAGE(PG8_SB(0, 0), cB, voffB); PG8_STAGE(PG8_SA(0, 0), cA, voffA); PG8_STAGE(PG8_SB(0, 1), cB + hB, voffB); PG8_STAGE(PG8_SA(0, 1), cA + hA, voffA);
        if (wr == 1) PG8_BAR;
        PG8_WAIT_V(4); PG8_BAR;
        PG8_STAGE(PG8_SB(1, 0), cB + kstep, voffB); PG8_STAGE(PG8_SA(1, 0), cA + kstep, voffA); PG8_STAGE(PG8_SB(1, 1), cB + hB + kstep, voffB);
        PG8_WAIT_V(6); PG8_BAR;
    }
    for (;;) {
        const bool has_next = S.next(ui + 1, nxt);
        const char* nA = has_next ? nxt.A : cA; const char* nB = has_next ? nxt.B : cB;
        for (int t = 0; t < nt; t += 2) {
            const bool last = (t == nt - 2);
            const char* a1 = cA + (size_t)(t + 1) * kstep;
            const char* a2 = last ? nA : cA + (size_t)(t + 2) * kstep; const char* b2 = last ? nB : cB + (size_t)(t + 2) * kstep;
            const char* a3 = a2 + kstep; const char* b3 = b2 + kstep;
            if (last && has_next) S.a_ready(nxt);
            if constexpr (SP2) {
            PG8_LDB(B0, 0, 0); PG8_LDB(B1, 0, 1); PG8_SCHED; PG8_LDA(At, 0, 0); PG8_STAGE(PG8_SA(1, 1), a1 + hA, voffA);
            PG8_WAIT_V(8); PG8_WAIT_L(0); PG8_BAR; PG8_MMA(0, 0, At, B0); PG8_MMA(0, 1, At, B1); PG8_BAR; PG8_SCHED;
            PG8_LDA(At, 0, 1); PG8_STAGE(PG8_SB(0, 0), b2, voffB); PG8_STAGE(PG8_SB(0, 1), b2 + hB, voffB); PG8_STAGE(PG8_SA(0, 0), a2, voffA);
            PG8_WAIT_V(8); PG8_WAIT_L(0); PG8_BAR; PG8_MMA(1, 0, At, B0); PG8_MMA(1, 1, At, B1); PG8_BAR; PG8_SCHED;
            PG8_LDB(B0, 1, 0); PG8_LDB(B1, 1, 1); PG8_SCHED; PG8_LDA(At, 1, 0); PG8_STAGE(PG8_SA(0, 1), a2 + hA, voffA);
            PG8_WAIT_V(8); PG8_WAIT_L(0); PG8_BAR; PG8_MMA(0, 0, At, B0); PG8_MMA(0, 1, At, B1); PG8_BAR; PG8_SCHED;
            PG8_LDA(At, 1, 1); PG8_STAGE(PG8_SB(1, 0), b3, voffB); PG8_STAGE(PG8_SB(1, 1), b3 + hB, voffB); PG8_STAGE(PG8_SA(1, 0), a3, voffA);
            PG8_WAIT_V(8); PG8_WAIT_L(0); PG8_BAR; PG8_MMA(1, 0, At, B0); PG8_MMA(1, 1, At, B1); PG8_BAR; PG8_SCHED;
            } else {
            PG8_LDB(B0, 0, 0); PG8_SCHED; PG8_LDA(At, 0, 0); PG8_STAGE(PG8_SA(1, 1), a1 + hA, voffA);
            PG8_WAIT_L(8); PG8_BAR; PG8_WAIT_L(0); PG8_MMA(0, 0, At, B0); PG8_BAR; PG8_SCHED;
            PG8_LDB(B1, 0, 1); PG8_STAGE(PG8_SB(0, 0), b2, voffB);
            PG8_BAR; PG8_WAIT_L(0); PG8_MMA(0, 1, At, B1); PG8_BAR;
            PG8_LDA(At, 0, 1); PG8_STAGE(PG8_SA(0, 0), a2, voffA);
            PG8_BAR; PG8_WAIT_L(0); PG8_MMA(1, 0, At, B0); PG8_BAR; PG8_SCHED;
            PG8_STAGE(PG8_SB(0, 1), b2 + hB, voffB);
            PG8_WAIT_V(6); PG8_BAR; PG8_MMA(1, 1, At, B1); PG8_BAR;
            PG8_LDB(B0, 1, 0); PG8_SCHED; PG8_LDA(At, 1, 0); PG8_STAGE(PG8_SA(0, 1), a2 + hA, voffA);
            PG8_WAIT_L(8); PG8_BAR; PG8_WAIT_L(0); PG8_MMA(0, 0, At, B0); PG8_BAR; PG8_SCHED;
            PG8_LDB(B1, 1, 1); PG8_STAGE(PG8_SB(1, 0), b3, voffB);
            PG8_BAR; PG8_WAIT_L(0); PG8_MMA(0, 1, At, B1); PG8_BAR;
            PG8_LDA(At, 1, 1); PG8_STAGE(PG8_SA(1, 0), a3, voffA);
            PG8_BAR; PG8_WAIT_L(0); PG8_MMA(1, 0, At, B0); PG8_BAR; PG8_SCHED;
            PG8_STAGE(PG8_SB(1, 1), b3 + hB, voffB);
            PG8_WAIT_V(6); PG8_BAR; PG8_MMA(1, 1, At, B1); PG8_BAR;
            }
        }
        if constexpr (ALIGN_EPI) { if (wr == 0) PG8_BAR; }
        E(acc, cur, wr, wc, fr, fq); S.done(cur);
        if (!has_next) break;
#pragma unroll
        for (int a = 0; a < 2; ++a)
#pragma unroll
            for (int b = 0; b < 2; ++b)
#pragma unroll
                for (int m = 0; m < 4; ++m)
#pragma unroll
                    for (int n = 0; n < 2; ++n) acc[a][b][m][n] = (f32x4){0.f, 0.f, 0.f, 0.f};
        cur = nxt; cA = nA; cB = nB; ++ui;
        if constexpr (ALIGN_EPI) { if (wr == 1) PG8_BAR; }
    }
    PG8_WAIT_V(0);
    if constexpr (!ALIGN_EPI) { if (wr == 0) PG8_BAR; }
    PG8_BAR;
#undef PG8_SA
#undef PG8_SB
#undef PG8_STAGE
#undef PG8_LDA
#undef PG8_LDB
#undef PG8_MMA
#undef PG8_WAIT_V
#undef PG8_WAIT_L
#undef PG8_BAR
#undef PG8_SCHED
}

struct SchedPlain {
    TileOrder o; const char* A; const char* B; size_t at, bt;
    __device__ __forceinline__ bool next(int i, Unit& u) const { if (!o.tile(i, u.pm, u.pn)) return false; u.A = A + (size_t)u.pm * at; u.B = B + (size_t)u.pn * bt; u.mode = 0; return true; }
    __device__ __forceinline__ void a_ready(const Unit&) const {}
    __device__ __forceinline__ void done(const Unit&) const {}
};

struct EpiG1 {
    bf16* P;
    __device__ __forceinline__ void operator()(const f32x4 (&acc)[2][2][4][2], const Unit& u, int wr, int wc, int fr, int fq) const {
        const int row0 = u.pm * BM + wr * 64 + fr, col0 = u.pn * BM + wc * 32 + 8 * fq;
        const int act = u.pn < 4 ? 1 : (u.pn >= 10 ? 2 : 0);
#pragma unroll
        for (int ai = 0; ai < 2; ++ai)
#pragma unroll
            for (int m = 0; m < 4; ++m) { bf16* rowp = P + (size_t)(row0 + ai * HALF + m * 16) * DIN + col0;
#pragma unroll
                for (int bj = 0; bj < 2; ++bj) { f32x4 v0 = acc[ai][bj][m][0], v1 = acc[ai][bj][m][1];
                    if (act == 1) { v0 = v0 * C2; v1 = v1 * C2; }
                    else if (act == 2) {
#pragma unroll
                        for (int j = 0; j < 4; ++j) { v0[j] = fsig(v0[j]); v1[j] = fsig(v1[j]); } }
                    u32x4 w; w.x = cvt_pk_bf16(v0[0], v0[1]); w.y = cvt_pk_bf16(v0[2], v0[3]); w.z = cvt_pk_bf16(v1[0], v1[1]); w.w = cvt_pk_bf16(v1[2], v1[3]);
                    *(u32x4*)(rowp + bj * HALF) = w; } }
    }
};

struct SchedS1 {
    TileOrder o; const char* P; const char* Wg; const char* Wo;
    __device__ __forceinline__ bool next(int i, Unit& u) const {
        const int ti = i / 3, st = i - 3 * ti; if (!o.tile(ti, u.pm, u.pn)) return false;
        const size_t arow = (size_t)u.pm * 256 * DIN * 2;
        u.mode = st;
        u.A = P + arow + (st == 2 ? CQ : CU) * 2;
        u.B = st == 2 ? Wo + (size_t)u.pn * 256 * D * 2 : Wg + (size_t)((st == 0 ? D : 0) + u.pn * 256) * D * 2;
        return true; }
    __device__ __forceinline__ void a_ready(const Unit&) const {}
    __device__ __forceinline__ void done(const Unit&) const {}
};
__device__ __forceinline__ void unpack8(const u32x4 w, float (&f)[8]) { f[0] = bflo(w.x); f[1] = bfhi(w.x); f[2] = bflo(w.y); f[3] = bfhi(w.y); f[4] = bflo(w.z); f[5] = bfhi(w.z); f[6] = bflo(w.w); f[7] = bfhi(w.w); }
struct EpiS1 {
    const bf16* P; bf16* T;
    __device__ __forceinline__ void operator()(const f32x4 (&acc)[2][2][4][2], const Unit& u, int wr, int wc, int fr, int fq) const {
        const int row0 = u.pm * BM + wr * 64 + fr, col0 = u.pn * BM + wc * 32 + 8 * fq; const int mode = u.mode;
#pragma unroll
        for (int ai = 0; ai < 2; ++ai)
#pragma unroll
            for (int m = 0; m < 4; ++m) { const size_t row = (size_t)(row0 + ai * HALF + m * 16);
#pragma unroll
                for (int bj = 0; bj < 2; ++bj) { const int col = col0 + bj * HALF; const f32x4 v0 = acc[ai][bj][m][0], v1 = acc[ai][bj][m][1];
                    float a[8] = {v0[0], v0[1], v0[2], v0[3], v1[0], v1[1], v1[2], v1[3]}, r[8];
                    bf16* tp = T + row * D + col;
                    if (mode == 0) { float g[8]; unpack8(*(const u32x4*)(P + row * DIN + CGS + col), g);
#pragma unroll
                        for (int j = 0; j < 8; ++j) r[j] = g[j] * fsig(a[j]); }
                    else if (mode == 1) { float t[8]; unpack8(*(const u32x4*)tp, t);
#pragma unroll
                        for (int j = 0; j < 8; ++j) r[j] = a[j] * t[j]; }
                    else { float g[8], t[8]; unpack8(*(const u32x4*)(P + row * DIN + CGA + col), g); unpack8(*(const u32x4*)tp, t);
#pragma unroll
                        for (int j = 0; j < 8; ++j) r[j] = g[j] * a[j] + t[j]; }
                    u32x4 w; w.x = cvt_pk_bf16(r[0], r[1]); w.y = cvt_pk_bf16(r[2], r[3]); w.z = cvt_pk_bf16(r[4], r[5]); w.w = cvt_pk_bf16(r[6], r[7]);
                    *(u32x4*)tp = w; } }
    }
};
struct EpiS2 {
    const float* xp; const float* xs; float* OUT; bf16* XN2; float* ssq;
    __device__ __forceinline__ void operator()(const f32x4 (&acc)[2][2][4][2], const Unit& u, int wr, int wc, int fr, int fq) const {
        const int row0 = u.pm * BM + wr * 64 + fr, col0 = u.pn * BM + wc * 32 + 8 * fq;
        const float* xb = (u.pm * BM < MP) ? xp + (size_t)(u.pm * BM) * D : xs + (size_t)(u.pm * BM - MP) * D;
#pragma unroll
        for (int ai = 0; ai < 2; ++ai)
#pragma unroll
            for (int m = 0; m < 4; ++m) { const int rl = wr * 64 + fr + ai * HALF + m * 16; const size_t row = (size_t)(u.pm * BM + rl); float q = 0.f;
#pragma unroll
                for (int bj = 0; bj < 2; ++bj) { const int col = col0 + bj * HALF;
                    const f32x4 xa = *(const f32x4*)(xb + (size_t)rl * D + col), xc = *(const f32x4*)(xb + (size_t)rl * D + col + 4);
                    const f32x4 v0 = acc[ai][bj][m][0] + xa, v1 = acc[ai][bj][m][1] + xc;
                    *(f32x4*)(OUT + row * D + col) = v0; *(f32x4*)(OUT + row * D + col + 4) = v1;
                    q += (v0[0] * v0[0] + v0[1] * v0[1]) + (v0[2] * v0[2] + v0[3] * v0[3]) + (v1[0] * v1[0] + v1[1] * v1[1]) + (v1[2] * v1[2] + v1[3] * v1[3]);
                    u32x4 w; w.x = cvt_pk_bf16(v0[0], v0[1]); w.y = cvt_pk_bf16(v0[2], v0[3]); w.z = cvt_pk_bf16(v1[0], v1[1]); w.w = cvt_pk_bf16(v1[2], v1[3]);
                    *(u32x4*)(XN2 + row * D + col) = w; }
                q += __shfl_xor(q, 16); q += __shfl_xor(q, 32);
                if (fq == 0) ssq[row * 16 + u.pn * 4 + wc] = q; }
    }
};
__device__ __forceinline__ float rstd16(const float* ssq, size_t row) {
    const f32x4 a = *(const f32x4*)(ssq + row * 16), b = *(const f32x4*)(ssq + row * 16 + 4), c = *(const f32x4*)(ssq + row * 16 + 8), d = *(const f32x4*)(ssq + row * 16 + 12);
    const float s = ((a[0] + a[1]) + (a[2] + a[3])) + ((b[0] + b[1]) + (b[2] + b[3])) + ((c[0] + c[1]) + (c[2] + c[3])) + ((d[0] + d[1]) + (d[2] + d[3]));
    return __builtin_amdgcn_rsqf(s * (1.f / D) + EPS);
}
struct EpiS3 {
    const float* ssq; bf16* H;
    __device__ __forceinline__ void operator()(const f32x4 (&acc)[2][2][4][2], const Unit& u, int wr, int wc, int fr, int fq) const {
        const int row0 = u.pm * BM + wr * 64 + fr, col0 = u.pn * BM + wc * 32 + 8 * fq;
#pragma unroll
        for (int ai = 0; ai < 2; ++ai)
#pragma unroll
            for (int m = 0; m < 4; ++m) { const size_t row = (size_t)(row0 + ai * HALF + m * 16); const float rs = rstd16(ssq, row);
#pragma unroll
                for (int bj = 0; bj < 2; ++bj) { f32x4 v0 = acc[ai][bj][m][0] * rs, v1 = acc[ai][bj][m][1] * rs;
#pragma unroll
                    for (int j = 0; j < 4; ++j) { const float a = fmaxf(v0[j], 0.f), b = fmaxf(v1[j], 0.f); v0[j] = a * a; v1[j] = b * b; }
                    u32x4 w; w.x = cvt_pk_bf16(v0[0], v0[1]); w.y = cvt_pk_bf16(v0[2], v0[3]); w.z = cvt_pk_bf16(v1[0], v1[1]); w.w = cvt_pk_bf16(v1[2], v1[3]);
                    *(u32x4*)(H + row * DIN + col0 + bj * HALF) = w; } }
    }
};
struct EpiS4 {
    float* OUT; float* ssq;
    __device__ __forceinline__ void operator()(const f32x4 (&acc)[2][2][4][2], const Unit& u, int wr, int wc, int fr, int fq) const {
        const int row0 = u.pm * BM + wr * 64 + fr, col0 = u.pn * BM + wc * 32 + 8 * fq;
#pragma unroll
        for (int ai = 0; ai < 2; ++ai)
#pragma unroll
            for (int m = 0; m < 4; ++m) { const size_t row = (size_t)(row0 + ai * HALF + m * 16); float q = 0.f;
#pragma unroll
                for (int bj = 0; bj < 2; ++bj) { float* op = OUT + row * D + col0 + bj * HALF;
                    const f32x4 v0 = acc[ai][bj][m][0] + *(const f32x4*)op, v1 = acc[ai][bj][m][1] + *(const f32x4*)(op + 4);
                    *(f32x4*)op = v0; *(f32x4*)(op + 4) = v1;
                    q += (v0[0] * v0[0] + v0[1] * v0[1]) + (v0[2] * v0[2] + v0[3] * v0[3]) + (v1[0] * v1[0] + v1[1] * v1[1]) + (v1[2] * v1[2] + v1[3] * v1[3]); }
                q += __shfl_xor(q, 16); q += __shfl_xor(q, 32);
                if (fq == 0) ssq[row * 16 + u.pn * 4 + wc] = q; }
    }
};
}
namespace att {
typedef short bf16x8 __attribute__((ext_vector_type(8)));
typedef short s16x4 __attribute__((ext_vector_type(4)));
typedef float f32x16 __attribute__((ext_vector_type(16)));
typedef float f32x4 __attribute__((ext_vector_type(4)));
typedef unsigned u32x4 __attribute__((ext_vector_type(4)));
#define ALAS __attribute__((address_space(3)))
__device__ __forceinline__ int crow(int r, int h) { return (r & 3) + 8 * (r >> 2) + 4 * h; }
__device__ __forceinline__ unsigned cvtpk(float lo, float hi) { unsigned r; asm volatile("v_cvt_pk_bf16_f32 %0, %1, %2" : "=v"(r) : "v"(lo), "v"(hi)); return r; }
__device__ __forceinline__ bf16x8 pack8(const f32x4 a, const f32x4 b) { u32x4 w; w.x = cvtpk(a[0], a[1]); w.y = cvtpk(a[2], a[3]); w.z = cvtpk(b[0], b[1]); w.w = cvtpk(b[2], b[3]); return __builtin_bit_cast(bf16x8, w); }
__device__ __forceinline__ float swapmax(float m) { auto rr = __builtin_amdgcn_permlane32_swap(__float_as_uint(m), __float_as_uint(m), false, false); return fmaxf(__uint_as_float(rr[0]), __uint_as_float(rr[1])); }
__device__ __forceinline__ float swapsum(float m) { auto rr = __builtin_amdgcn_permlane32_swap(__float_as_uint(m), __float_as_uint(m), false, false); return __uint_as_float(rr[0]) + __uint_as_float(rr[1]); }
__device__ __forceinline__ s16x4 vtr(const ALAS char* p) { typedef short v4i16_t __attribute__((ext_vector_type(4))); return __builtin_bit_cast(s16x4, __builtin_amdgcn_ds_read_tr16_b64_v4i16((ALAS v4i16_t*)p)); }

template <bool SAMPLE>
__device__ __forceinline__ void attn_wave(int i0, int i1, int i2, bf16* P, const float* ck, const float* cv, const float* sinks, ALAS char* vslot, ALAS float* wsf, ALAS bf16* stg, int lane) {
    const int r32 = lane & 31, hi = lane >> 5;
    int b = 0, hq = 0, q0 = 0, kvh, db = 0, kbase = 0;
    if (!SAMPLE) { b = i0; hq = i1; q0 = i2; kvh = hq >> 2; kbase = (q0 & ~63) - 128; } else { db = i0; kvh = i1; }
    bf16x8 qf[4]; float sink_l;
    { size_t qoff;
      if (!SAMPLE) { qoff = (size_t)(b * SEQ + q0 + r32) * DIN + CQ + hq * HD; sink_l = sinks[hq] * LOG2E; }
      else { const int c = r32 & 15; qoff = (size_t)(MP + db * DS + (c & 3)) * DIN + CQ + (kvh * 4 + (c >> 2)) * HD; sink_l = sinks[kvh * 4 + (c >> 2)] * LOG2E; }
#pragma unroll
      for (int d0 = 0; d0 < 4; ++d0) qf[d0] = *(const bf16x8*)(P + qoff + 16 * d0 + 8 * hi); }
    f32x16 p[6];
#pragma unroll
    for (int ht = 0; ht < 6; ++ht) {
        bf16x8 kf[4]; const int js = 32 * ht + r32;
        if (!SAMPLE || ht >= 4) {
            size_t koff;
            if (!SAMPLE) { int kr = kbase + js; kr = kr < 0 ? 0 : kr; koff = (size_t)(b * SEQ + kr) * DIN + CK + kvh * HD; }
            else { int jj = js - WIN; jj = jj > DS - 1 ? DS - 1 : jj; koff = (size_t)(MP + db * DS + jj) * DIN + CK + kvh * HD; }
#pragma unroll
            for (int d0 = 0; d0 < 4; ++d0) kf[d0] = *(const bf16x8*)(P + koff + 16 * d0 + 8 * hi);
        } else {
            const float* kp = ck + ((size_t)(db * WIN + js) * NKV + kvh) * HD + 8 * hi;
#pragma unroll
            for (int d0 = 0; d0 < 4; ++d0) kf[d0] = pack8(*(const f32x4*)(kp + 16 * d0), *(const f32x4*)(kp + 16 * d0 + 4));
        }
        f32x16 acc = {};
#pragma unroll
        for (int d0 = 0; d0 < 4; ++d0) acc = __builtin_amdgcn_mfma_f32_32x32x16_bf16(kf[d0], qf[d0], acc, 0, 0, 0);
        p[ht] = acc;
    }
    float mx = sink_l;
#pragma unroll
    for (int ht = 0; ht < 6; ++ht)
#pragma unroll
        for (int r = 0; r < 16; ++r) { const int js = 32 * ht + crow(r, hi); bool ok;
            if (!SAMPLE) { const int kp = kbase + js, df = q0 + r32 - kp; ok = kp >= 0 && df >= 0 && df < WIN; }
            else { const int t = r32 & 3; ok = js >= t + 1 && js <= t + WIN; }
            const float s = ok ? p[ht][r] : -INFINITY; p[ht][r] = s; mx = fmaxf(mx, s); }
    mx = swapmax(mx);
    float l = 0.f;
#pragma unroll
    for (int ht = 0; ht < 6; ++ht)
#pragma unroll
        for (int r = 0; r < 16; ++r) { const float e = __builtin_amdgcn_exp2f(p[ht][r] - mx); p[ht][r] = e; l += e; }
    l = swapsum(l) + __builtin_amdgcn_exp2f(sink_l - mx);
    f32x16 o0 = {}, o1 = {};
    const ALAS char* vp0 = vslot + ((lane >> 4) & 1) * 32 + (lane & 3) * 8 + (4 * hi + ((lane & 15) >> 2)) * 64;
#pragma unroll
    for (int t = 0; t < 3; ++t) {
#pragma unroll
        for (int i = 0; i < 8; ++i) { const int cidx = lane + 64 * i, key = cidx >> 3, ch = cidx & 7, js = 64 * t + key; bf16x8 v;
            if (!SAMPLE || t == 2) { size_t voff;
                if (!SAMPLE) { int kr = kbase + js; kr = kr < 0 ? 0 : kr; voff = (size_t)(b * SEQ + kr) * DIN + CV + kvh * HD; }
                else { int jj = js - WIN; jj = jj > DS - 1 ? DS - 1 : jj; voff = (size_t)(MP + db * DS + jj) * DIN + CV + kvh * HD; }
                v = *(const bf16x8*)(P + voff + 8 * ch); }
            else { const float* vp = cv + ((size_t)(db * WIN + js) * NKV + kvh) * HD + 8 * ch; v = pack8(*(const f32x4*)vp, *(const f32x4*)(vp + 4)); }
            *(ALAS bf16x8*)(vslot + ((ch >> 2) * 4 + (key >> 4)) * 1024 + (key & 15) * 64 + (ch & 3) * 16) = v; }
#pragma unroll
        for (int hh = 0; hh < 2; ++hh)
#pragma unroll
            for (int s = 0; s < 2; ++s) { const int k16 = 2 * hh + s; const f32x16 pp = p[2 * t + hh];
                const bf16x8 pa = s == 0 ? pack8((f32x4){pp[0], pp[1], pp[2], pp[3]}, (f32x4){pp[4], pp[5], pp[6], pp[7]}) : pack8((f32x4){pp[8], pp[9], pp[10], pp[11]}, (f32x4){pp[12], pp[13], pp[14], pp[15]});
                const s16x4 a0 = vtr(vp0 + k16 * 1024), a1 = vtr(vp0 + k16 * 1024 + 512), b0 = vtr(vp0 + (4 + k16) * 1024), b1 = vtr(vp0 + (4 + k16) * 1024 + 512);
                const bf16x8 v0 = {a0[0], a0[1], a0[2], a0[3], a1[0], a1[1], a1[2], a1[3]}, v1 = {b0[0], b0[1], b0[2], b0[3], b1[0], b1[1], b1[2], b1[3]};
                o0 = __builtin_amdgcn_mfma_f32_32x32x16_bf16(pa, v0, o0, 0, 0, 0);
                o1 = __builtin_amdgcn_mfma_f32_32x32x16_bf16(pa, v1, o1, 0, 0, 0); }
    }
    if (hi == 0) wsf[r32] = l;
    float rli[16];
#pragma unroll
    for (int r = 0; r < 16; ++r) rli[r] = __builtin_amdgcn_rcpf(wsf[crow(r, hi)]);
#pragma unroll
    for (int r = 0; r < 16; ++r) { const int orow = crow(r, hi); stg[orow * 64 + r32] = f2bf(o0[r] * rli[r]); stg[orow * 64 + 32 + r32] = f2bf(o1[r] * rli[r]); }
#pragma unroll
    for (int i = 0; i < (SAMPLE ? 2 : 4); ++i) { const int row = i * 8 + (lane >> 3), ch = lane & 7; const u32x4 v = *(const ALAS u32x4*)(stg + row * 64 + ch * 8);
        size_t ooff;
        if (!SAMPLE) ooff = (size_t)(b * SEQ + q0 + row) * DIN + CQ + hq * HD + ch * 8;
        else ooff = (size_t)(MP + db * DS + (row & 3)) * DIN + CQ + (kvh * 4 + (row >> 2)) * HD + ch * 8;
        *(u32x4*)(P + ooff) = v; }
}
constexpr int N_PUNITS = NB * NKV * (SEQ / 64);
constexpr int N_SUNITS = DB * NKV / 8;
__device__ __forceinline__ void attn_phase(ALAS unsigned char* lds, int G, int vcu, int wave, int lane, bf16* P, const float* ck, const float* cv, const float* sinks) {
    ALAS char* vslot = (ALAS char*)lds + wave * 8192; ALAS bf16* stg = (ALAS bf16*)(lds + 65536 + wave * 4096); ALAS float* wsf = (ALAS float*)(lds + 98304 + wave * 256);
    for (int u = vcu; u < N_PUNITS + N_SUNITS; u += G) {
        if (u < N_PUNITS) { const int bk = u >> 7, qb = u & 127; attn_wave<false>(bk >> 2, (bk & 3) * 4 + (wave >> 1), qb * 64 + (wave & 1) * 32, P, ck, cv, sinks, vslot, wsf, stg, lane); }
        else { const int it = (u - N_PUNITS) * 8 + wave; attn_wave<true>(it >> 2, it & 3, 0, P, ck, cv, sinks, vslot, wsf, stg, lane); }
    }
}
#undef ALAS
}
namespace ssm {
typedef short bf16x8 __attribute__((ext_vector_type(8)));
typedef float f32x16 __attribute__((ext_vector_type(16)));
typedef float f32x4 __attribute__((ext_vector_type(4)));
typedef unsigned u32x4 __attribute__((ext_vector_type(4)));
typedef unsigned u32x2 __attribute__((ext_vector_type(2)));
#define SLAS __attribute__((address_space(3)))
constexpr int TCH = 16, NCHUNK = MP / TCH;
constexpr size_t XO_MV = 0, XO_W = 12 * MiB, XO_HIN = 16 * MiB;
constexpr size_t TB_A16 = TB_END, TB_A4 = TB_A16 + NG * NST * 2, TB_END2 = TB_A4 + NG * NST * 2;
__device__ __forceinline__ unsigned cvtpk(float lo, float hi) { unsigned r; asm volatile("v_cvt_pk_bf16_f32 %0, %1, %2" : "=v"(r) : "v"(lo), "v"(hi)); return r; }
__device__ __forceinline__ bf16x8 pack8(const f32x4 a, const f32x4 b) { u32x4 w; w.x = cvtpk(a[0], a[1]); w.y = cvtpk(a[2], a[3]); w.z = cvtpk(b[0], b[1]); w.w = cvtpk(b[2], b[3]); return __builtin_bit_cast(bf16x8, w); }
__device__ __forceinline__ float gelu_f(float x) { const float z = 0.7978845608028654f * (x + 0.044715f * x * x * x); return x * __builtin_amdgcn_rcpf(1.f + __builtin_amdgcn_exp2f(-2.f * 1.4426950408889634f * z)); }

__device__ __forceinline__ void build_group(int g, int tid, SLAS unsigned char* lds, const float* lre, const float* lim, const float* ldt, const float* bre, const float* bim,
                                            const float* cre, const float* cim, float* tab, bf16* MV, bf16* W) {
    SLAS float* pw = (SLAS float*)lds;
    SLAS float* bbr = pw + 17 * 64 * 2;
    SLAS float* bbi = bbr + 64 * 16;
    SLAS float* cr = bbi + 64 * 16;
    SLAS float* ci = cr + 16 * 64;
    SLAS float* kg = ci + 16 * 64;
    __syncthreads();
    if (tid < 64) { const int p = tid;
        const double dt = exp((double)ldt[g]), lr = lre[g * NST + p], li = lim[g * NST + p];
        const double dec = exp(lr * dt), ar = dec * cos(li * dt), ai = dec * sin(li * dt);
        const double nr = ar - 1.0, ni = ai, den = lr * lr + li * li;
        const double fr = (nr * lr + ni * li) / den, fi = (ni * lr - nr * li) / den;
        tab[TB_A + (g * NST + p) * 2 + 0] = (float)ar; tab[TB_A + (g * NST + p) * 2 + 1] = (float)ai;
        for (int c = 0; c < NCH; ++c) {
            const double br = bre[(g * NST + p) * NCH + c], bi = bim[(g * NST + p) * NCH + c];
            const float vr = (float)(fr * br - fi * bi), vi = (float)(fr * bi + fi * br);
            tab[TB_BB + ((size_t)(g * NST + p) * NCH + c) * 2 + 0] = vr; tab[TB_BB + ((size_t)(g * NST + p) * NCH + c) * 2 + 1] = vi;
            bbr[p * 16 + c] = vr; bbi[p * 16 + c] = vi; }
        double xr = 1.0, xi = 0.0;
        for (int l = 0; l <= 16; ++l) { pw[(l * 64 + p) * 2] = (float)xr; pw[(l * 64 + p) * 2 + 1] = (float)xi;
            if (l == 4) { tab[TB_A4 + (g * NST + p) * 2] = (float)xr; tab[TB_A4 + (g * NST + p) * 2 + 1] = (float)xi; }
            if (l == 16) { tab[TB_A16 + (g * NST + p) * 2] = (float)xr; tab[TB_A16 + (g * NST + p) * 2 + 1] = (float)xi; }
            const double tr = xr * ar - xi * ai, ti = xr * ai + xi * ar; xr = tr; xi = ti; } }
    for (int i = tid; i < 16 * 64; i += 512) { cr[i] = cre[g * NCH * NST + i]; ci[i] = cim[g * NCH * NST + i]; }
    __syncthreads();
    for (int e = tid; e < 4096; e += 512) { const int lag = e >> 8, c = (e >> 4) & 15, c2 = e & 15; float s = 0.f;
        for (int p = 0; p < 64; ++p) { const float ar = pw[(lag * 64 + p) * 2], ai = pw[(lag * 64 + p) * 2 + 1], br = bbr[p * 16 + c2], bi = bbi[p * 16 + c2];
            s += cr[c * 64 + p] * (ar * br - ai * bi) - ci[c * 64 + p] * (ar * bi + ai * br); }
        kg[e] = s; }
    __syncthreads();
    bf16* mv = MV + (size_t)g * 256 * 384; bf16* w = W + (size_t)g * 128 * 256;
    for (int ch = tid; ch < 256 * 48; ch += 512) { const int row = ch / 48, cc = ch % 48, t = row >> 4, c = row & 15; float v[8];
        if (cc < 32) { const int s = cc >> 1, c0 = (cc & 1) * 8;
#pragma unroll
            for (int j = 0; j < 8; ++j) v[j] = t >= s ? kg[((t - s) * 16 + c) * 16 + c0 + j] : 0.f; }
        else { const bool im = cc >= 40; const int p0 = ((cc - 32) & 7) * 8;
#pragma unroll
            for (int j = 0; j < 8; ++j) { const int p = p0 + j; const float ar = pw[((t + 1) * 64 + p) * 2], ai = pw[((t + 1) * 64 + p) * 2 + 1], xr = cr[c * 64 + p], xi = ci[c * 64 + p];
                v[j] = im ? -(xr * ai + xi * ar) : (xr * ar - xi * ai); } }
        u32x4 o; o.x = cvtpk(v[0], v[1]); o.y = cvtpk(v[2], v[3]); o.z = cvtpk(v[4], v[5]); o.w = cvtpk(v[6], v[7]);
        *(u32x4*)(mv + (size_t)row * 384 + cc * 8) = o; }
    for (int ch = tid; ch < 128 * 32; ch += 512) { const int row = ch >> 5, cc = ch & 31, p = row & 63, s = cc >> 1, c0 = (cc & 1) * 8; const bool im = row >= 64; float v[8];
        const float ar = pw[((15 - s) * 64 + p) * 2], ai = pw[((15 - s) * 64 + p) * 2 + 1];
#pragma unroll
        for (int j = 0; j < 8; ++j) { const float br = bbr[p * 16 + c0 + j], bi = bbi[p * 16 + c0 + j]; v[j] = im ? (ar * bi + ai * br) : (ar * br - ai * bi); }
        u32x4 o; o.x = cvtpk(v[0], v[1]); o.y = cvtpk(v[2], v[3]); o.z = cvtpk(v[4], v[5]); o.w = cvtpk(v[6], v[7]);
        *(u32x4*)(w + (size_t)row * 256 + cc * 8) = o; }
    __syncthreads();
}

template <bool SAMPLE>
__device__ __forceinline__ void ssmA_wave(int g, int nt, const bf16* P, const bf16* W, float* S, const float* tab, const float* s0r, const float* s0i, float* outr, float* outi, int lane) {
    const int n = lane & 31, h = lane >> 5, cn = nt * 32 + n;
    const size_t rowb = SAMPLE ? (size_t)MP + (size_t)cn * DS : (size_t)cn * TCH;
    const bf16* wg = W + (size_t)g * 128 * 256;
    f32x16 acc[4] = {};
#pragma unroll
    for (int ks = (SAMPLE ? 12 : 0); ks < 16; ++ks) { const int tok = SAMPLE ? ks - 12 : ks;
        const bf16x8 bfr = *(const bf16x8*)(P + (rowb + tok) * DIN + CU + g * NCH + 8 * h);
#pragma unroll
        for (int rt = 0; rt < 4; ++rt) { const bf16x8 afr = *(const bf16x8*)(wg + (size_t)(32 * rt + n) * 256 + 16 * ks + 8 * h);
            acc[rt] = __builtin_amdgcn_mfma_f32_32x32x16_bf16(afr, bfr, acc[rt], 0, 0, 0); } }
    if (!SAMPLE) {
        float* sp = S + ((size_t)g * NCHUNK + cn) * 128;
#pragma unroll
        for (int rt = 0; rt < 4; ++rt)
#pragma unroll
            for (int q4 = 0; q4 < 4; ++q4) *(f32x4*)(sp + 32 * rt + 8 * q4 + 4 * h) = (f32x4){acc[rt][4 * q4], acc[rt][4 * q4 + 1], acc[rt][4 * q4 + 2], acc[rt][4 * q4 + 3]};
    } else {
#pragma unroll
        for (int rt = 0; rt < 2; ++rt)
#pragma unroll
            for (int q4 = 0; q4 < 4; ++q4) { const int p0 = 32 * rt + 8 * q4 + 4 * h; const size_t so = ((size_t)cn * NG + g) * NST + p0;
                const f32x4 hr = *(const f32x4*)(s0r + so), hi = *(const f32x4*)(s0i + so); f32x4 orr, oi;
#pragma unroll
                for (int i = 0; i < 4; ++i) { const float ar = tab[TB_A4 + (g * NST + p0 + i) * 2], ai = tab[TB_A4 + (g * NST + p0 + i) * 2 + 1];
                    orr[i] = ar * hr[i] - ai * hi[i] + acc[rt][4 * q4 + i]; oi[i] = ar * hi[i] + ai * hr[i] + acc[rt + 2][4 * q4 + i]; }
                *(f32x4*)(outr + so) = orr; *(f32x4*)(outi + so) = oi; }
    }
}
__device__ __forceinline__ void ssm_recur_wave(int b, int g, const float* S, bf16* Hin, const float* tab, float* outr, float* outi, int lane) {
    const int p = lane; const float ar = tab[TB_A16 + (g * NST + p) * 2], ai = tab[TB_A16 + (g * NST + p) * 2 + 1];
    const float* sp = S + ((size_t)g * NCHUNK + (size_t)b * (SEQ / TCH)) * 128; bf16* hp = Hin + ((size_t)g * NCHUNK + (size_t)b * (SEQ / TCH)) * 128;
    float hr = 0.f, hi = 0.f;
    for (int k0 = 0; k0 < SEQ / TCH; k0 += 8) { float sr[8], si[8];
#pragma unroll
        for (int j = 0; j < 8; ++j) { sr[j] = sp[(size_t)(k0 + j) * 128 + p]; si[j] = sp[(size_t)(k0 + j) * 128 + 64 + p]; }
#pragma unroll
        for (int j = 0; j < 8; ++j) { hp[(size_t)(k0 + j) * 128 + p] = f2bf(hr); hp[(size_t)(k0 + j) * 128 + 64 + p] = f2bf(hi);
            const float nr = ar * hr - ai * hi + sr[j], ni = ar * hi + ai * hr + si[j]; hr = nr; hi = ni; } }
    outr[((size_t)b * NG + g) * NST + p] = hr; outi[((size_t)b * NG + g) * NST + p] = hi;
}
template <bool SAMPLE, int RT0, int NRT>
__device__ __forceinline__ void ssmC_pass(int g, int cn, int h, int r32, size_t rowb, bf16* P, const bf16* mv, const bf16* Hin, const float* s0r, const float* s0i, const float* dsk) {
    f32x16 acc[NRT] = {};
    constexpr int KSMAX = SAMPLE ? 4 : (2 * (RT0 + NRT - 1) + 2 > 16 ? 16 : 2 * (RT0 + NRT - 1) + 2);
#pragma unroll
    for (int ks = 0; ks < KSMAX; ++ks) {
        const bf16x8 bfr = *(const bf16x8*)(P + (rowb + ks) * DIN + CU + g * NCH + 8 * h);
#pragma unroll
        for (int i = 0; i < NRT; ++i) { const int rt = RT0 + i; if (ks <= 2 * rt + 1) {
            const bf16x8 afr = *(const bf16x8*)(mv + (size_t)(32 * rt + r32) * 384 + 16 * ks + 8 * h);
            acc[i] = __builtin_amdgcn_mfma_f32_32x32x16_bf16(afr, bfr, acc[i], 0, 0, 0); } } }
#pragma unroll
    for (int j = 0; j < 8; ++j) { bf16x8 hfr;
        if (!SAMPLE) hfr = *(const bf16x8*)(Hin + ((size_t)g * NCHUNK + cn) * 128 + 16 * j + 8 * h);
        else { const float* src = (j < 4 ? s0r : s0i) + ((size_t)cn * NG + g) * NST + 16 * (j & 3) + 8 * h; hfr = pack8(*(const f32x4*)src, *(const f32x4*)(src + 4)); }
#pragma unroll
        for (int i = 0; i < NRT; ++i) { const bf16x8 afr = *(const bf16x8*)(mv + (size_t)(32 * (RT0 + i) + r32) * 384 + 256 + 16 * j + 8 * h);
            acc[i] = __builtin_amdgcn_mfma_f32_32x32x16_bf16(afr, hfr, acc[i], 0, 0, 0); } }
    const f32x4 d0 = *(const f32x4*)(dsk + g * NCH + 4 * h), d1 = *(const f32x4*)(dsk + g * NCH + 8 + 4 * h);
#pragma unroll
    for (int i = 0; i < NRT; ++i)
#pragma unroll
        for (int q4 = 0; q4 < 4; ++q4) { const int t = 2 * (RT0 + i) + (q4 >> 1), c0 = 8 * (q4 & 1) + 4 * h; const f32x4 dv = (q4 & 1) ? d1 : d0;
            bf16* up = P + (rowb + t) * DIN + CU + g * NCH + c0; const u32x2 uw = *(const u32x2*)up;
            const float u0 = __builtin_bit_cast(float, uw.x << 16), u1 = __builtin_bit_cast(float, uw.x & 0xffff0000u), u2 = __builtin_bit_cast(float, uw.y << 16), u3 = __builtin_bit_cast(float, uw.y & 0xffff0000u);
            const float y0 = gelu_f(acc[i][4 * q4] + dv[0] * u0), y1 = gelu_f(acc[i][4 * q4 + 1] + dv[1] * u1), y2 = gelu_f(acc[i][4 * q4 + 2] + dv[2] * u2), y3 = gelu_f(acc[i][4 * q4 + 3] + dv[3] * u3);
            u32x2 o; o.x = cvtpk(y0, y1); o.y = cvtpk(y2, y3); *(u32x2*)up = o; }
}
template <bool SAMPLE>
__device__ __forceinline__ void ssmC_wave(int g, int nt, bf16* P, const bf16* MV, const bf16* Hin, const float* s0r, const float* s0i, const float* dsk, int lane) {
    const int r32 = lane & 31, h = lane >> 5, cn = nt * 32 + r32;
    const size_t rowb = SAMPLE ? (size_t)MP + (size_t)cn * DS : (size_t)cn * TCH;
    const bf16* mv = MV + (size_t)g * 256 * 384;
    if (!SAMPLE) { ssmC_pass<false, 4, 4>(g, cn, h, r32, rowb, P, mv, Hin, s0r, s0i, dsk); asm volatile("" ::: "memory"); ssmC_pass<false, 0, 4>(g, cn, h, r32, rowb, P, mv, Hin, s0r, s0i, dsk); }
    else ssmC_pass<true, 0, 2>(g, cn, h, r32, rowb, P, mv, Hin, s0r, s0i, dsk);
}
constexpr int NWI_P = NG * (NCHUNK / 32);
constexpr int NWI_S = NG * (DB / 32);
#undef SLAS
}
constexpr int NWAVES = 8;
constexpr int RING_BYTES = 131072, LDSCTL_OFF = RING_BYTES, MISC_OFF = LDSCTL_OFF + 320, LDS_BYTES = 147456;
constexpr size_t CTL_ZERO_BYTES = 1 * MiB;
constexpr int CW_TMO = 0, CW_CODE = 1, CW_BAR = 4096;
#define GAS __attribute__((address_space(1)))
#define LAS __attribute__((address_space(3)))
typedef unsigned v4u __attribute__((ext_vector_type(4)));
typedef float f32x4 __attribute__((ext_vector_type(4)));
typedef GAS unsigned gu32;
#define RLX_AGENT __ATOMIC_RELAXED, __HIP_MEMORY_SCOPE_AGENT
#define LDS_WAIT() asm volatile("s_waitcnt lgkmcnt(0)" ::: "memory")
#define VM_WAIT() asm volatile("s_waitcnt vmcnt(0)" ::: "memory")
__device__ __forceinline__ unsigned pk2(float lo, float hi) { return (unsigned)f2bf(lo) | ((unsigned)f2bf(hi) << 16); }

#define XB_TMO      128
#define XB_XCNT(j)  (256  + 64 * (j))
#define XB_XSUB(j)  (1280 + 64 * (j))
#define XB_XGEN(j)  (2304 + 64 * (j))
#define XB_TOP      3328
#define XB_TOPGEN   3392
#define XCD_BAR_WORDS 3456
#define XB_SPIN_CAP (1u << 18)
__device__ __forceinline__ unsigned xb_ld(unsigned* p)              { return __hip_atomic_load(p, __ATOMIC_RELAXED, __HIP_MEMORY_SCOPE_AGENT); }
__device__ __forceinline__ unsigned xb_add(unsigned* p, unsigned v) { return __hip_atomic_fetch_add(p, v, __ATOMIC_RELAXED, __HIP_MEMORY_SCOPE_AGENT); }
__device__ __forceinline__ unsigned xb_xcc_id() { return (unsigned)__builtin_amdgcn_s_getreg((3 << 11) | 20) & 0xFu; }
#define XB_SPIN(cond, bar) do { unsigned _sp = 0; while (cond) { __builtin_amdgcn_s_sleep(1); \
    if ((++_sp & 255u) == 0u) { if (xb_ld(&(bar)[XB_TMO])) break; if (_sp > XB_SPIN_CAP) { atomicAdd(&(bar)[XB_TMO], 1u); break; } } } } while (0)
struct XcdBarrier { unsigned* bar; unsigned x; volatile LAS unsigned* st; };
__device__ __forceinline__ XcdBarrier xcd_barrier_post(unsigned* bar, volatile LAS unsigned* st) {
    XcdBarrier b; b.bar = bar; b.x = xb_xcc_id(); b.st = st;
    if (threadIdx.x == 0) (void)xb_add(&bar[XB_XCNT(b.x)], 1u);
    return b;
}
__device__ __forceinline__ void xcd_barrier_complete(unsigned* bar, unsigned x, unsigned& nloc, unsigned& nx) {
    const unsigned G = gridDim.x * gridDim.y * gridDim.z;
    unsigned sum, cnt, mine, sp = 0u;
    for (;;) {
        sum = 0u; cnt = 0u; mine = 0u;
#pragma unroll
        for (unsigned j = 0; j < 16; ++j) { const unsigned c = xb_ld(&bar[XB_XCNT(j)]); sum += c; cnt += (c > 0u) ? 1u : 0u; mine = (j == x) ? c : mine; }
        if (sum == G) break;
        __builtin_amdgcn_s_sleep(1);
        if ((++sp & 255u) == 0u) { if (xb_ld(&bar[XB_TMO])) break; if (sp > XB_SPIN_CAP) { atomicAdd(&bar[XB_TMO], 1u); break; } }
    }
    nloc = mine > 0u ? mine : 1u; nx = cnt > 0u ? cnt : 1u;
}
__device__ __forceinline__ void xcd_barrier(const XcdBarrier& b) {
    asm volatile("s_waitcnt vmcnt(0)" ::: "memory");
    __syncthreads();
    if (threadIdx.x == 0) {
        unsigned* bar = b.bar;
        __builtin_amdgcn_s_waitcnt(0);
        unsigned nloc = b.st[0], nx = b.st[1];
        if (nloc == 0u) { xcd_barrier_complete(bar, b.x, nloc, nx); b.st[0] = nloc; b.st[1] = nx; }
        const unsigned old = xb_add(&bar[XB_XSUB(b.x)], 1u);
        const unsigned gen = old / nloc;
        if (old + 1u == (gen + 1u) * nloc) {
            __builtin_amdgcn_fence(__ATOMIC_RELEASE, "agent");
            asm volatile("s_waitcnt vmcnt(0)" ::: "memory");
            const unsigned og = xb_add(&bar[XB_TOP], 1u);
            const unsigned tg = og / nx;
            if (og + 1u == (tg + 1u) * nx) xb_add(&bar[XB_TOPGEN], 1u);
            else XB_SPIN(xb_ld(&bar[XB_TOPGEN]) == tg, bar);
            __builtin_amdgcn_fence(__ATOMIC_ACQUIRE, "agent");
            xb_add(&bar[XB_XGEN(b.x)], 1u);
            asm volatile("s_waitcnt vmcnt(0)" ::: "memory");
        } else {
            XB_SPIN(xb_ld(&bar[XB_XGEN(b.x)]) == gen, bar);
            __builtin_amdgcn_fence(__ATOMIC_ACQUIRE, "agent");
            asm volatile("s_waitcnt vmcnt(0)" ::: "memory");
        }
    }
    __syncthreads();
}

struct Args { const float* in[24]; float* out; unsigned char* ws; int ph_lo, ph_hi, li, pad; };
struct Frame { LAS unsigned char* lds; volatile LAS unsigned* MISC; gu32* ctl; int tid, lane, wave, vcu, G; };

__device__ __forceinline__ float wave_sum(float v) {
#pragma unroll
    for (int o = 1; o < 64; o <<= 1) v += __shfl_xor(v, o);
    return v;
}
__device__ __forceinline__ void p0_transpose_item(const float* W, const float* scale, int K, int N, bf16* WT, LAS float* scr, int item, int lane) {
    const int nblk = N / 32, kb = item / nblk, nb = item % nblk, k0 = 64 * kb, n0 = 32 * nb;
#pragma unroll 8
    for (int i = 0; i < 32; ++i) { const int kk = 2 * i + (lane >> 5); float v = W[(size_t)(k0 + kk) * N + n0 + (lane & 31)]; if (scale) v *= scale[k0 + kk]; scr[kk * 33 + (lane & 31)] = v; }
    LDS_WAIT(); asm volatile("" ::: "memory");
    const int c = lane & 7;
#pragma unroll
    for (int j = 0; j < 4; ++j) { const int n = (lane >> 3) + 8 * j; const LAS float* s = scr + (8 * c) * 33 + n;
        v4u o; o.x = pk2(s[0 * 33], s[1 * 33]); o.y = pk2(s[2 * 33], s[3 * 33]); o.z = pk2(s[4 * 33], s[5 * 33]); o.w = pk2(s[6 * 33], s[7 * 33]);
        *(GAS v4u*)(WT + (size_t)(n0 + n) * K + k0 + 8 * c) = o; }
    LDS_WAIT(); asm volatile("" ::: "memory");
}
__device__ __forceinline__ void rms_row_to_bf16(int lane, const float* xrow_, bf16* orow) {
    const GAS f32x4* xr = (const GAS f32x4*)xrow_ + lane;
    f32x4 v[4]; float s = 0.f;
#pragma unroll
    for (int j = 0; j < 4; ++j) { v[j] = xr[64 * j]; s += (v[j].x * v[j].x + v[j].y * v[j].y) + (v[j].z * v[j].z + v[j].w * v[j].w); }
    const float rstd = rsqrtf(wave_sum(s) * (1.f / D) + EPS);
    GAS unsigned long long* o8 = (GAS unsigned long long*)orow + lane;
#pragma unroll
    for (int j = 0; j < 4; ++j) o8[64 * j] = (unsigned long long)pk2(v[j].x * rstd, v[j].y * rstd) | ((unsigned long long)pk2(v[j].z * rstd, v[j].w * rstd) << 32);
}
__device__ __forceinline__ void ssm_tab_group(int g, int p, const float* lre, const float* lim, const float* ldt, const float* bre, const float* bim, float* tab) {
    const double dt = exp((double)ldt[g]), lr = lre[g * NST + p], li = lim[g * NST + p];
    const double dec = exp(lr * dt), ar = dec * cos(li * dt), ai = dec * sin(li * dt);
    const double nr = ar - 1.0, ni = ai, den = lr * lr + li * li;
    const double fr = (nr * lr + ni * li) / den, fi = (ni * lr - nr * li) / den;
    tab[TB_A + (g * NST + p) * 2 + 0] = (float)ar; tab[TB_A + (g * NST + p) * 2 + 1] = (float)ai;
    for (int c = 0; c < NCH; ++c) {
        const double br = bre[(g * NST + p) * NCH + c], bi = bim[(g * NST + p) * NCH + c];
        tab[TB_BB + ((size_t)(g * NST + p) * NCH + c) * 2 + 0] = (float)(fr * br - fi * bi);
        tab[TB_BB + ((size_t)(g * NST + p) * NCH + c) * 2 + 1] = (float)(fr * bi + fi * br);
    }
}
__device__ __forceinline__ void p0_prologue(Frame& F, const Args& a) {
    unsigned char* ws = a.ws;
    LAS float* scr = (LAS float*)(F.lds + F.wave * 16384);
    const int gw = F.vcu * NWAVES + F.wave, NGW = F.G * NWAVES;
    constexpr int I_IN = (D / 64) * (DIN / 32), I_SQ = (D / 64) * (D / 32), I_GLU = (D / 64) * (2 * D / 32), I_UP = (D / 64) * (DFF / 32), I_DN = (DFF / 64) * (D / 32);
    constexpr int NITEMS = I_IN + I_SQ + I_GLU + I_SQ + I_UP + I_DN;
    for (int it = gw; it < NITEMS; it += NGW) {
        int r = it;
        if (r < I_IN) { p0_transpose_item(a.in[7], a.in[6], D, DIN, (bf16*)(ws + WS_WIN), scr, r, F.lane); continue; } r -= I_IN;
        if (r < I_SQ) { p0_transpose_item(a.in[9], nullptr, D, D, (bf16*)(ws + WS_WO), scr, r, F.lane); continue; } r -= I_SQ;
        if (r < I_GLU) { p0_transpose_item(a.in[18], nullptr, D, 2 * D, (bf16*)(ws + WS_WGLU), scr, r, F.lane); continue; } r -= I_GLU;
        if (r < I_SQ) { p0_transpose_item(a.in[19], nullptr, D, D, (bf16*)(ws + WS_WOUT), scr, r, F.lane); continue; } r -= I_SQ;
        if (r < I_UP) { p0_transpose_item(a.in[21], a.in[20], D, DFF, (bf16*)(ws + WS_WUP), scr, r, F.lane); continue; } r -= I_UP;
        p0_transpose_item(a.in[22], nullptr, DFF, D, (bf16*)(ws + WS_WDN), scr, r, F.lane);
    }
    bf16* XN = (bf16*)(ws + WS_XN);
    for (int m = gw; m < M; m += NGW) rms_row_to_bf16(F.lane, xrow(a.in[0], a.in[1], m), XN + (size_t)m * D);
    for (int g = F.vcu; g < NG; g += F.G) ssm::build_group(g, F.tid, F.lds, a.in[10], a.in[11], a.in[12], a.in[13], a.in[14], a.in[15], a.in[16], (float*)(ws + WS_TAB), (bf16*)(ws + WS_XN2 + ssm::XO_MV), (bf16*)(ws + WS_XN2 + ssm::XO_W));
}

__global__ void __launch_bounds__(NWAVES * 64, 2) mk_fwd(Args args) {
    extern __shared__ __attribute__((aligned(16))) unsigned char lds[];
    Frame F;
    F.lds = (LAS unsigned char*)lds;
    F.MISC = (volatile LAS unsigned*)(F.lds + MISC_OFF);
    F.tid = threadIdx.x; F.lane = F.tid & 63; F.wave = __builtin_amdgcn_readfirstlane(F.tid >> 6);
    F.G = gridDim.x; { const int bx = blockIdx.x; F.vcu = (F.G % 8 == 0) ? (bx % 8) * (F.G / 8) + bx / 8 : bx; }
    unsigned char* ws = args.ws;
    F.ctl = (gu32*)(ws + WS_CTL);
    for (int u = F.tid; u < (LDS_BYTES - LDSCTL_OFF) / 4; u += NWAVES * 64) ((LAS unsigned*)(F.lds + LDSCTL_OFF))[u] = 0u;
    __syncthreads();
    XcdBarrier bar = xcd_barrier_post((unsigned*)(F.ctl + CW_BAR) + args.li * XCD_BAR_WORDS, F.MISC + 8);
    const int lo = args.ph_lo, hi = args.ph_hi;
#define IN(k) (lo <= (k) && (k) < hi)
#define BOTH(k) (IN(k) && IN((k) + 1))
    if (IN(0)) { p0_prologue(F, args); if (BOTH(0)) xcd_barrier(bar); }
    if (IN(1)) {
        pg8::Geo g{D, D};
        pg8::SchedPlain S; S.o.init(M / 256, DIN / 256, F.G, (int)blockIdx.x); S.A = (const char*)(ws + WS_XN); S.B = (const char*)(ws + WS_WIN); S.at = (size_t)256 * D * 2; S.bt = (size_t)256 * D * 2;
        pg8::EpiG1 E{(bf16*)(ws + WS_P)};
        pg8::gemm_phase<pg8::EpiG1, pg8::SchedPlain, true, true>(F.lds, g, S, E);
        if (BOTH(1)) xcd_barrier(bar);
    }


    if (IN(2)) {
        att::attn_phase(F.lds, F.G, F.vcu, F.wave, F.lane, (bf16*)(ws + WS_P), args.in[2], args.in[3], args.in[8]);
        { const bf16* P = (const bf16*)(ws + WS_P); const float* ck = args.in[2]; const float* cv = args.in[3]; float* out = args.out;
          const size_t NP = (size_t)NB * WIN * DKV, NS = (size_t)DB * WIN * DKV;
          for (size_t i = (size_t)F.vcu * (NWAVES * 64) + F.tid; i < NP + NS; i += (size_t)F.G * NWAVES * 64) {
              if (i < NP) { const int c = i % DKV, j = (i / DKV) % WIN, b = i / ((size_t)DKV * WIN); const size_t r = (size_t)(b * SEQ + SEQ - WIN + j) * DIN;
                  out[O_KP + i] = bf2f(P[r + CK + c]); out[O_VP + i] = bf2f(P[r + CV + c]); }
              else { const size_t k = i - NP; const int c = k % DKV, j = (k / DKV) % WIN, db = k / ((size_t)DKV * WIN);
                  if (j < WIN - DS) { out[O_KS + k] = ck[((size_t)db * WIN + j + DS) * DKV + c]; out[O_VS + k] = cv[((size_t)db * WIN + j + DS) * DKV + c]; }
                  else { const size_t r = (size_t)(MP + db * DS + (j - (WIN - DS))) * DIN; out[O_KS + k] = bf2f(P[r + CK + c]); out[O_VS + k] = bf2f(P[r + CV + c]); } } } }

        { const int gw = F.vcu * NWAVES + F.wave, NGW = F.G * NWAVES;
          const bf16* P = (const bf16*)(ws + WS_P); const bf16* W = (const bf16*)(ws + WS_XN2 + ssm::XO_W); float* S = (float*)(ws + WS_XN); const float* tab = (const float*)(ws + WS_TAB);
          for (int wi = gw; wi < ssm::NWI_P + ssm::NWI_S; wi += NGW) {
              if (wi < ssm::NWI_P) ssm::ssmA_wave<false>(wi >> 5, wi & 31, P, W, S, tab, nullptr, nullptr, nullptr, nullptr, F.lane);
              else { const int si = wi - ssm::NWI_P; ssm::ssmA_wave<true>(si >> 2, si & 3, P, W, S, tab, args.in[4], args.in[5], args.out + O_HRS, args.out + O_HIS, F.lane); } } }
        if (BOTH(2)) xcd_barrier(bar);
    }
    if (IN(3)) {
        const int gw = F.vcu * NWAVES + F.wave;
        if (gw < NB * NG) ssm::ssm_recur_wave(gw / NG, gw % NG, (const float*)(ws + WS_XN), (bf16*)(ws + WS_XN2 + ssm::XO_HIN), (const float*)(ws + WS_TAB), args.out + O_HRP, args.out + O_HIP, F.lane);
        if (BOTH(3)) xcd_barrier(bar);
    }
    if (IN(4)) {
        const int gw = F.vcu * NWAVES + F.wave, NGW = F.G * NWAVES;
        bf16* P = (bf16*)(ws + WS_P); const bf16* MV = (const bf16*)(ws + WS_XN2 + ssm::XO_MV); const bf16* Hin = (const bf16*)(ws + WS_XN2 + ssm::XO_HIN);
        for (int wi = gw; wi < ssm::NWI_P + ssm::NWI_S; wi += NGW) {
            if (wi < ssm::NWI_P) ssm::ssmC_wave<false>(wi >> 5, wi & 31, P, MV, Hin, nullptr, nullptr, args.in[17], F.lane);
            else { const int si = wi - ssm::NWI_P; ssm::ssmC_wave<true>(si >> 2, si & 3, P, MV, Hin, args.in[4], args.in[5], args.in[17], F.lane); } }
        if (BOTH(4)) xcd_barrier(bar);
    }
    if (IN(5)) {
        pg8::Geo g{DIN, D};
        pg8::SchedS1 S; S.o.init(M / 256, D / 256, F.G, (int)blockIdx.x); S.P = (const char*)(ws + WS_P); S.Wg = (const char*)(ws + WS_WGLU); S.Wo = (const char*)(ws + WS_WO);
        pg8::EpiS1 E{(const bf16*)(ws + WS_P), (bf16*)(ws + WS_XN)};
        pg8::gemm_phase<pg8::EpiS1, pg8::SchedS1, true, true>(F.lds, g, S, E);
        if (BOTH(5)) xcd_barrier(bar);
    }
    if (IN(6)) {
        pg8::Geo g{D, D};
        pg8::SchedPlain S; S.o.init(M / 256, D / 256, F.G, (int)blockIdx.x); S.A = (const char*)(ws + WS_XN); S.B = (const char*)(ws + WS_WOUT); S.at = (size_t)256 * D * 2; S.bt = (size_t)256 * D * 2;
        pg8::EpiS2 E{args.in[0], args.in[1], args.out, (bf16*)(ws + WS_XN2), (float*)(ws + WS_RS)};
        pg8::gemm_phase<pg8::EpiS2, pg8::SchedPlain, true, true>(F.lds, g, S, E);
        if (BOTH(6)) xcd_barrier(bar);
    }
    if (IN(7)) {
        pg8::Geo g{D, D};
        pg8::SchedPlain S; S.o.init(M / 256, DFF / 256, F.G, (int)blockIdx.x); S.A = (const char*)(ws + WS_XN2); S.B = (const char*)(ws + WS_WUP); S.at = (size_t)256 * D * 2; S.bt = (size_t)256 * D * 2;
        pg8::EpiS3 E{(const float*)(ws + WS_RS), (bf16*)(ws + WS_P)};
        pg8::gemm_phase<pg8::EpiS3, pg8::SchedPlain, true, true>(F.lds, g, S, E);
        if (BOTH(7)) xcd_barrier(bar);
    }
    if (IN(8)) {
        pg8::Geo g{DIN, DFF};
        pg8::SchedPlain S; S.o.init(M / 256, D / 256, F.G, (int)blockIdx.x); S.A = (const char*)(ws + WS_P); S.B = (const char*)(ws + WS_WDN); S.at = (size_t)256 * DIN * 2; S.bt = (size_t)256 * DFF * 2;
        pg8::EpiS4 E{args.out, (float*)(ws + WS_RS) + (size_t)M * 16};
        pg8::gemm_phase<pg8::EpiS4, pg8::SchedPlain, true, true>(F.lds, g, S, E);
        if (BOTH(8)) xcd_barrier(bar);
    }
    if (IN(9)) {
        const float* ssq2 = (const float*)(ws + WS_RS) + (size_t)M * 16; const float* gf = args.in[23];
        const int gw = F.vcu * NWAVES + F.wave, NGW = F.G * NWAVES;
        f32x4 gv[4];
#pragma unroll
        for (int j = 0; j < 4; ++j) gv[j] = *((const f32x4*)gf + F.lane + 64 * j);
        for (int m = gw; m < M; m += NGW) { const float rs = pg8::rstd16(ssq2, (size_t)m); f32x4* o = (f32x4*)(args.out + (size_t)m * D) + F.lane;
#pragma unroll
            for (int j = 0; j < 4; ++j) o[64 * j] = o[64 * j] * rs * gv[j]; }
    }
#undef IN
#undef BOTH
}
extern "C" void kernel_launch(void* const* d_in, const int* in_sizes, int n_in, void* d_out, int out_size, void* d_ws, size_t ws_size, hipStream_t stream) {
    if (n_in != 24 || (size_t)out_size != O_END || ws_size < WS_END) return;
    static int grid = 0;
    if (grid == 0) {
        int dev = 0, cus = 0, per_cu = 0;
        if (hipGetDevice(&dev) != hipSuccess || hipDeviceGetAttribute(&cus, hipDeviceAttributeMultiprocessorCount, dev) != hipSuccess) { grid = -1; return; }
        if (hipFuncSetAttribute((const void*)mk_fwd, hipFuncAttributeMaxDynamicSharedMemorySize, LDS_BYTES) != hipSuccess) { grid = -1; return; }
        if (hipOccupancyMaxActiveBlocksPerMultiprocessor(&per_cu, (const void*)mk_fwd, NWAVES * 64, LDS_BYTES) != hipSuccess || per_cu < 1) per_cu = 1;
        (void)hipGetLastError();
        grid = cus * (per_cu > 1 ? 1 : per_cu);
    }
    if (grid < 0) return;
    const float* xp = (const float*)d_in[0]; const float* xs = (const float*)d_in[1];
    const float* ck = (const float*)d_in[2]; const float* cv = (const float*)d_in[3];
    const float* s0r = (const float*)d_in[4]; const float* s0i = (const float*)d_in[5];
    const float* sinks = (const float*)d_in[8];
    const float* cre = (const float*)d_in[15]; const float* cim = (const float*)d_in[16];
    const float* dsk = (const float*)d_in[17]; const float* g_fin = (const float*)d_in[23];
    unsigned char* ws = (unsigned char*)d_ws; float* out = (float*)d_out;
    bf16* Wo = (bf16*)(ws + WS_WO); bf16* Wg = (bf16*)(ws + WS_WGLU); bf16* Wu = (bf16*)(ws + WS_WOUT); bf16* Wp = (bf16*)(ws + WS_WUP); bf16* Wd = (bf16*)(ws + WS_WDN);
    bf16* XN = (bf16*)(ws + WS_XN); bf16* P = (bf16*)(ws + WS_P); bf16* XN2 = (bf16*)(ws + WS_XN2); float* tab = (float*)(ws + WS_TAB); float* rs = (float*)(ws + WS_RS);
    bf16* T = XN;
    (void)hipMemsetAsync(ws + WS_CTL, 0, CTL_ZERO_BYTES, stream);
    Args a{};
    for (int i = 0; i < 24; ++i) a.in[i] = (const float*)d_in[i];
    a.out = out; a.ws = ws; a.ph_lo = 0; a.ph_hi = 10; a.li = 0;
    hipLaunchKernelGGL(mk_fwd, dim3(grid), dim3(NWAVES * 64), LDS_BYTES, stream, a);
}
```
